# Optimizing an MI355X kernel written in HIP

```python
import math
import jax, jax.numpy as jnp
from jax import lax
import numpy as np

D_MODEL = 1024
BATCH = 8
SEQ = 4096
DEPTH = 1

HEAD_DIM = 64
D_MIX = D_MODEL
MOBA_HEADS = (D_MIX // 2) // HEAD_DIM
NSA_HEADS = (D_MIX // 2) // HEAD_DIM
NSA_KV_GROUPS = 2
MOBA_BLOCK = 256
MOBA_TOPK = 3
MOBA_QCHUNK = 32
NSA_CMP_LEN = 32
NSA_CMP_STRIDE = 16
NSA_CMP_HIDDEN = 256
NSA_SLC_BLOCK = 64
NSA_SLC_TOPN = 16
NSA_WINDOW = 512
NSA_QCHUNK = 64
NSA_N_GATES = 3
REL_BUCKETS = 32
REL_MAX_EXACT = REL_BUCKETS // 2
REL_MAX_DIST = 128
N_BIAS_HEADS = MOBA_HEADS + NSA_HEADS
D_FF = 2816
RMS_EPS = 1e-6
PROJ_SIZES = (MOBA_HEADS * HEAD_DIM,) * 3 + (NSA_HEADS * HEAD_DIM,) + (NSA_KV_GROUPS * HEAD_DIM,) * 6 + (NSA_HEADS * NSA_N_GATES,)
D_IN_PROJ = sum(PROJ_SIZES)
PROJ_SPLITS = tuple(int(s) for s in np.cumsum(PROJ_SIZES)[:-1])

kernel_name = 'hybrid_moba_nsa_macaron'


def rmsnorm(x, g):
    xf = x.astype(jnp.float32)
    y = xf * lax.rsqrt(jnp.mean(xf * xf, axis=-1, keepdims=True) + RMS_EPS)
    return (y * g.astype(jnp.float32)).astype(x.dtype)


def swiglu(h, w_gate, w_up, w_down):
    return (jax.nn.silu(h @ w_gate) * (h @ w_up)) @ w_down


def rel_bucket(dist):
    n = jnp.maximum(dist, 0)
    is_small = n < REL_MAX_EXACT
    nf = jnp.maximum(n, 1).astype(jnp.float32)
    large = REL_MAX_EXACT + (jnp.log(nf / REL_MAX_EXACT) / math.log(REL_MAX_DIST / REL_MAX_EXACT) * (REL_BUCKETS - REL_MAX_EXACT)).astype(jnp.int32)
    return jnp.where(is_small, n, jnp.minimum(large, REL_BUCKETS - 1))


def masked_softmax(logits, mask):
    lf = jnp.where(mask, logits.astype(jnp.float32), -jnp.inf)
    m = jnp.max(lf, axis=-1, keepdims=True)
    m = jnp.where(jnp.isfinite(m), m, 0.0)
    p = jnp.exp(lf - m)
    den = jnp.sum(p, axis=-1, keepdims=True)
    return p / jnp.where(den > 0, den, 1.0)


def slc_overlap(n_cmp, n_slc):
    r = NSA_SLC_BLOCK // NSA_CMP_STRIDE
    mc = NSA_CMP_LEN // NSA_CMP_STRIDE
    j = np.arange(n_slc)
    offs = (np.arange(r)[:, None] + np.arange(mc)[None, :]).reshape(-1)
    c = r * j[:, None] + offs[None, :]
    w = np.zeros((n_slc * r + mc, n_slc), np.float32)
    np.add.at(w, (c, np.broadcast_to(j[:, None], c.shape)), 1.0)
    return w[:n_cmp]


def moba_attention(q, k, v, tab):
    B, H, S, dh = q.shape
    nblk = -(-S // MOBA_BLOCK)
    s_pad = nblk * MOBA_BLOCK
    pad = ((0, 0), (0, 0), (0, s_pad - S), (0, 0))
    kp = jnp.pad(k, pad)
    vp = jnp.pad(v, pad)
    k_blocks = kp.reshape(B, H, nblk, MOBA_BLOCK, dh)
    v_blocks = vp.reshape(B, H, nblk, MOBA_BLOCK, dh)
    k_mean = jnp.mean(k_blocks.astype(jnp.float32), axis=3).astype(k.dtype)
    topk = min(MOBA_TOPK, nblk)
    n_sel = topk * MOBA_BLOCK
    C = MOBA_QCHUNK
    n_chunks = S // C
    q_chunks = q.reshape(B, H, n_chunks, C, dh).transpose(2, 0, 1, 3, 4)
    bi = jnp.arange(B)[:, None, None, None]
    hi = jnp.arange(H)[None, :, None, None]
    blk_ids = jnp.arange(nblk)
    offs = jnp.arange(MOBA_BLOCK)
    scale = dh ** -0.5

    def chunk_fn(args):
        qc, c = args
        t = c * C + jnp.arange(C)
        cur = (c * C) // MOBA_BLOCK
        gate = jnp.einsum('bhcd,bhnd->bhcn', qc, k_mean).astype(jnp.float32)
        gate = jnp.where(blk_ids < cur, gate, -jnp.inf)
        _, sel = lax.top_k(gate, topk)
        k_sel = k_blocks[bi, hi, sel].reshape(B, H, C, n_sel, dh)
        v_sel = v_blocks[bi, hi, sel].reshape(B, H, C, n_sel, dh)
        pos_sel = (sel[..., None] * MOBA_BLOCK + offs).reshape(B, H, C, n_sel)
        mask_sel = jnp.repeat(sel < cur, MOBA_BLOCK, axis=-1)
        bias_sel = tab[hi, rel_bucket(t[:, None] - pos_sel)]
        k_own = lax.dynamic_slice_in_dim(kp, cur * MOBA_BLOCK, MOBA_BLOCK, axis=2)
        v_own = lax.dynamic_slice_in_dim(vp, cur * MOBA_BLOCK, MOBA_BLOCK, axis=2)
        d_own = t[:, None] - (cur * MOBA_BLOCK + offs)[None, :]
        mask_own = jnp.broadcast_to(d_own >= 0, (B, H, C, MOBA_BLOCK))
        bias_own = tab[:, rel_bucket(d_own)]
        lg_sel = jnp.einsum('bhcd,bhckd->bhck', qc, k_sel).astype(jnp.float32) * scale + bias_sel
        lg_own = jnp.einsum('bhcd,bhkd->bhck', qc, k_own).astype(jnp.float32) * scale + bias_own
        p = masked_softmax(jnp.concatenate([lg_sel, lg_own], axis=-1), jnp.concatenate([mask_sel, mask_own], axis=-1)).astype(v.dtype)
        return jnp.einsum('bhck,bhckd->bhcd', p[..., :n_sel], v_sel) + jnp.einsum('bhck,bhkd->bhcd', p[..., n_sel:], v_own)

    out = lax.map(chunk_fn, (q_chunks, jnp.arange(n_chunks)))
    return out.transpose(1, 2, 0, 3, 4).reshape(B, H, S, dh)


def nsa_attention(q, kc_raw, vc_raw, ks, vs, kw, vw, gates, tab, pos_k, w1_k, w2_k, pos_v, w1_v, w2_v):
    B, H, S, dh = q.shape
    G = kc_raw.shape[1]
    R = H // G
    scale = dh ** -0.5
    n_cmp = (S - NSA_CMP_LEN) // NSA_CMP_STRIDE + 1
    idx = (np.arange(n_cmp)[:, None] * NSA_CMP_STRIDE + np.arange(NSA_CMP_LEN)[None, :]).astype(np.int32)

    def compress(raw, pos, w1, w2):
        blocks = raw[:, :, idx] + pos
        return jax.nn.silu(blocks.reshape(B, G, n_cmp, NSA_CMP_LEN * dh) @ w1) @ w2

    k_cmp = compress(kc_raw, pos_k, w1_k, w2_k)
    v_cmp = compress(vc_raw, pos_v, w1_v, w2_v)
    cmp_end = jnp.asarray(np.arange(n_cmp, dtype=np.int32) * NSA_CMP_STRIDE + NSA_CMP_LEN - 1)
    n_slc = S // NSA_SLC_BLOCK
    n_top = min(NSA_SLC_TOPN, n_slc)
    n_sel = n_top * NSA_SLC_BLOCK
    overlap = jnp.asarray(slc_overlap(n_cmp, n_slc))
    ks_blocks = ks.reshape(B, G, n_slc, NSA_SLC_BLOCK, dh)
    vs_blocks = vs.reshape(B, G, n_slc, NSA_SLC_BLOCK, dh)
    wpad = ((0, 0), (0, 0), (NSA_WINDOW, 0), (0, 0))
    kw_pad = jnp.pad(kw, wpad)
    vw_pad = jnp.pad(vw, wpad)
    tab_g = tab.reshape(G, R, REL_BUCKETS)
    C = NSA_QCHUNK
    n_chunks = S // C
    q_chunks = q.reshape(B, G, R, n_chunks, C, dh).transpose(3, 0, 1, 2, 4, 5)
    g_chunks = gates.reshape(B, G, R, n_chunks, C, NSA_N_GATES).transpose(3, 0, 1, 2, 4, 5)
    bi = jnp.arange(B)[:, None, None, None]
    gi = jnp.arange(G)[None, :, None, None]
    gi5 = jnp.arange(G)[:, None, None, None]
    ri5 = jnp.arange(R)[:, None, None]
    slc_ids = jnp.arange(n_slc)
    offs = jnp.arange(NSA_SLC_BLOCK)
    win_offs = jnp.arange(NSA_WINDOW + C)

    def chunk_fn(args):
        qc, gc, c = args
        t = c * C + jnp.arange(C)
        d_cmp = t[:, None] - cmp_end[None, :]
        lg = jnp.einsum('bgrcd,bgnd->bgrcn', qc, k_cmp).astype(jnp.float32) * scale + tab_g[:, :, rel_bucket(d_cmp)]
        p_cmp = masked_softmax(lg, d_cmp >= 0)
        o_cmp = jnp.einsum('bgrcn,bgnd->bgrcd', p_cmp.astype(v_cmp.dtype), v_cmp)
        imp = jnp.einsum('bgrcn,nj->bgcj', p_cmp, overlap)
        cur = t // NSA_SLC_BLOCK
        forced = (slc_ids[None, :] == 0) | (slc_ids[None, :] == cur[:, None]) | (slc_ids[None, :] == cur[:, None] - 1)
        allowed = slc_ids[None, :] <= cur[:, None]
        score = jnp.where(forced, jnp.inf, jnp.where(allowed, imp, -jnp.inf))
        _, sel = lax.top_k(score, n_top)
        k_sel = ks_blocks[bi, gi, sel].reshape(B, G, C, n_sel, dh)
        v_sel = vs_blocks[bi, gi, sel].reshape(B, G, C, n_sel, dh)
        pos_sel = (sel[..., None] * NSA_SLC_BLOCK + offs).reshape(B, G, C, n_sel)
        d_sel = t[:, None] - pos_sel
        lg = jnp.einsum('bgrcd,bgckd->bgrck', qc, k_sel).astype(jnp.float32) * scale + tab_g[gi5, ri5, rel_bucket(d_sel)[:, :, None]]
        p_slc = masked_softmax(lg, (d_sel >= 0)[:, :, None]).astype(v_sel.dtype)
        o_slc = jnp.einsum('bgrck,bgckd->bgrcd', p_slc, v_sel)
        k_win = lax.dynamic_slice_in_dim(kw_pad, c * C, NSA_WINDOW + C, axis=2)
        v_win = lax.dynamic_slice_in_dim(vw_pad, c * C, NSA_WINDOW + C, axis=2)
        pos_win = c * C - NSA_WINDOW + win_offs
        d_win = t[:, None] - pos_win[None, :]
        mask_win = (pos_win[None, :] >= 0) & (d_win >= 0) & (d_win < NSA_WINDOW)
        lg = jnp.einsum('bgrcd,bgkd->bgrck', qc, k_win).astype(jnp.float32) * scale + tab_g[:, :, rel_bucket(d_win)]
        p_win = masked_softmax(lg, mask_win).astype(v_win.dtype)
        o_win = jnp.einsum('bgrck,bgkd->bgrcd', p_win, v_win)
        return gc[..., 0:1] * o_cmp + gc[..., 1:2] * o_slc + gc[..., 2:3] * o_win

    out = lax.map(chunk_fn, (q_chunks, g_chunks, jnp.arange(n_chunks)))
    return out.transpose(1, 2, 3, 0, 4, 5).reshape(B, H, S, dh)


def hybrid_mixer(h, w_in, pos_k, w1_k, w2_k, pos_v, w1_v, w2_v, w_out, rel_bias):
    B, S, _ = h.shape
    proj = h @ w_in
    qa, ka, va, qb, kcb, vcb, ksb, vsb, kwb, vwb, gb = jnp.split(proj, PROJ_SPLITS, axis=-1)

    def heads(t, n):
        return t.reshape(B, S, n, HEAD_DIM).transpose(0, 2, 1, 3)

    out_a = moba_attention(heads(qa, MOBA_HEADS), heads(ka, MOBA_HEADS), heads(va, MOBA_HEADS), rel_bias[:, :MOBA_HEADS].T)
    gates = jax.nn.sigmoid(gb.astype(jnp.float32)).astype(h.dtype).reshape(B, S, NSA_HEADS, NSA_N_GATES).transpose(0, 2, 1, 3)
    out_b = nsa_attention(heads(qb, NSA_HEADS), heads(kcb, NSA_KV_GROUPS), heads(vcb, NSA_KV_GROUPS), heads(ksb, NSA_KV_GROUPS), heads(vsb, NSA_KV_GROUPS), heads(kwb, NSA_KV_GROUPS), heads(vwb, NSA_KV_GROUPS), gates, rel_bias[:, MOBA_HEADS:].T, pos_k, w1_k, w2_k, pos_v, w1_v, w2_v)
    o = jnp.concatenate([out_a.transpose(0, 2, 1, 3).reshape(B, S, MOBA_HEADS * HEAD_DIM), out_b.transpose(0, 2, 1, 3).reshape(B, S, NSA_HEADS * HEAD_DIM)], axis=-1)
    return o @ w_out


def setup_inputs(seed: int = 0) -> dict:
    key = jax.random.key(seed)
    ks = jax.random.split(key, 20)

    def nrm(k, shape, s):
        return jax.random.normal(k, shape, jnp.float32) * s

    def gain(k, shape):
        return 1.0 + 0.05 * jax.random.normal(k, shape, jnp.float32)

    L = DEPTH
    flat_cmp = NSA_CMP_LEN * HEAD_DIM
    return {
        'x': nrm(ks[0], (BATCH, SEQ, D_MODEL), 1.0),
        'norm_ffn1': gain(ks[1], (L, D_MODEL)),
        'w_ffn1_gate': nrm(ks[2], (L, D_MODEL, D_FF), D_MODEL ** -0.5),
        'w_ffn1_up': nrm(ks[3], (L, D_MODEL, D_FF), D_MODEL ** -0.5),
        'w_ffn1_down': nrm(ks[4], (L, D_FF, D_MODEL), D_FF ** -0.5),
        'norm_mix': gain(ks[5], (L, D_MODEL)),
        'w_in': nrm(ks[6], (L, D_MODEL, D_IN_PROJ), D_MODEL ** -0.5),
        'cmp_pos_k': nrm(ks[7], (L, NSA_CMP_LEN, HEAD_DIM), 0.5),
        'cmp_w1_k': nrm(ks[8], (L, flat_cmp, NSA_CMP_HIDDEN), flat_cmp ** -0.5),
        'cmp_w2_k': nrm(ks[9], (L, NSA_CMP_HIDDEN, HEAD_DIM), NSA_CMP_HIDDEN ** -0.5),
        'cmp_pos_v': nrm(ks[10], (L, NSA_CMP_LEN, HEAD_DIM), 0.5),
        'cmp_w1_v': nrm(ks[11], (L, flat_cmp, NSA_CMP_HIDDEN), flat_cmp ** -0.5),
        'cmp_w2_v': nrm(ks[12], (L, NSA_CMP_HIDDEN, HEAD_DIM), NSA_CMP_HIDDEN ** -0.5),
        'w_out': nrm(ks[13], (L, D_MIX, D_MODEL), D_MIX ** -0.5),
        'norm_ffn2': gain(ks[14], (L, D_MODEL)),
        'w_ffn2_gate': nrm(ks[15], (L, D_MODEL, D_FF), D_MODEL ** -0.5),
        'w_ffn2_up': nrm(ks[16], (L, D_MODEL, D_FF), D_MODEL ** -0.5),
        'w_ffn2_down': nrm(ks[17], (L, D_FF, D_MODEL), D_FF ** -0.5),
        'rel_bias': nrm(ks[18], (REL_BUCKETS, N_BIAS_HEADS), 0.5),
        'norm_final': gain(ks[19], (D_MODEL,)),
    }


def reference(x, norm_ffn1, w_ffn1_gate, w_ffn1_up, w_ffn1_down, norm_mix, w_in, cmp_pos_k, cmp_w1_k, cmp_w2_k, cmp_pos_v, cmp_w1_v, cmp_w2_v, w_out, norm_ffn2, w_ffn2_gate, w_ffn2_up, w_ffn2_down, rel_bias, norm_final):
    for l in range(DEPTH):
        x = x + 0.5 * swiglu(rmsnorm(x, norm_ffn1[l]), w_ffn1_gate[l], w_ffn1_up[l], w_ffn1_down[l])
        x = x + hybrid_mixer(rmsnorm(x, norm_mix[l]), w_in[l], cmp_pos_k[l], cmp_w1_k[l], cmp_w2_k[l], cmp_pos_v[l], cmp_w1_v[l], cmp_w2_v[l], w_out[l], rel_bias)
        x = x + 0.5 * swiglu(rmsnorm(x, norm_ffn2[l]), w_ffn2_gate[l], w_ffn2_up[l], w_ffn2_down[l])
    return rmsnorm(x, norm_final)
```

```cpp
#include <hip/hip_runtime.h>
#include <cstdint>
#include <cstdio>

typedef unsigned short bf16_t;
typedef short bf16x8 __attribute__((ext_vector_type(8)));
typedef float f32x4 __attribute__((ext_vector_type(4)));
typedef float f32x16 __attribute__((ext_vector_type(16)));
typedef unsigned u32x4 __attribute__((ext_vector_type(4)));

constexpr int MTOK = 32768, DM = 1024, DFF = 2816, SEQ = 4096, NBATCH = 8, DINP = 2840;
constexpr float RMS_EPS = 1e-6f;
constexpr float LOG2E = 1.4426950408889634f;
constexpr float C2 = 0.125f * LOG2E;

constexpr size_t MiB = 1u << 20;
constexpr size_t WS_RSTD = 1 * MiB, WS_KMEAN = 2 * MiB, WS_KCMP = 3 * MiB, WS_VCMPT = 4 * MiB, WS_BIAS1 = 5 * MiB, WS_SSPART = 6 * MiB;
constexpr size_t WS_WGU1 = 8 * MiB, WS_WD1 = 19 * MiB, WS_WGU2 = 25 * MiB, WS_WD2 = 36 * MiB, WS_WINA = 42 * MiB, WS_WINB = 46 * MiB, WS_WOUT = 48 * MiB,
                 WS_W1K = 50 * MiB, WS_W1V = 51 * MiB, WS_PK = 52 * MiB, WS_PV = 60 * MiB;
constexpr size_t WS_XB = 72 * MiB, WS_H = 136 * MiB, WS_VT = 312 * MiB, WS_O = 376 * MiB, WS_END = 440 * MiB;
constexpr size_t WS_QA = WS_H, WS_KA = WS_H + 32 * MiB, WS_QB = WS_H + 64 * MiB, WS_KC = WS_H + 96 * MiB, WS_VC = WS_H + 104 * MiB, WS_KS = WS_H + 112 * MiB, WS_KW = WS_H + 120 * MiB;

__device__ __forceinline__ unsigned f2bf(float f) { unsigned u = __builtin_bit_cast(unsigned, f); return (u + 0x7fffu + ((u >> 16) & 1u)) >> 16; }
__device__ __forceinline__ float bf2f(unsigned short b) { return __builtin_bit_cast(float, (unsigned)b << 16); }
__device__ __forceinline__ unsigned pk2(float lo, float hi) { return f2bf(lo) | (f2bf(hi) << 16); }
__device__ __forceinline__ float wave_sum(float v) {
#pragma unroll
    for (int o = 1; o < 64; o <<= 1) v += __shfl_xor(v, o);
    return v;
}
__device__ __forceinline__ float wave_max(float v) {
#pragma unroll
    for (int o = 1; o < 64; o <<= 1) v = fmaxf(v, __shfl_xor(v, o));
    return v;
}
__device__ __forceinline__ int rel_bucket(int d) {
    if (d < 16) return d;
    return 16 + (d >= 19) + (d >= 21) + (d >= 24) + (d >= 27) + (d >= 31) + (d >= 35) + (d >= 40) + (d >= 46) + (d >= 52) + (d >= 59) + (d >= 67) + (d >= 77) + (d >= 87) + (d >= 99) + (d >= 113);
}
__device__ __forceinline__ int crow(int r, int hi) { return (r & 3) + 8 * (r >> 2) + 4 * hi; }

__device__ __forceinline__ void tr_item(const float* W, int N, int K, int col0, int nvalid, const float* gain, bf16_t* dst, int k0, float* scr, int lane) {
#pragma unroll 8
    for (int i = 0; i < 32; ++i) {
        const int kk = 2 * i + (lane >> 5), c = lane & 31;
        float v = 0.f;
        if (c < nvalid) { v = W[(size_t)(k0 + kk) * N + col0 + c]; if (gain) v *= gain[k0 + kk]; }
        scr[kk * 33 + c] = v;
    }
    asm volatile("s_waitcnt lgkmcnt(0)" ::: "memory");
    const int c8 = lane & 7;
#pragma unroll
    for (int j = 0; j < 4; ++j) {
        const int n = (lane >> 3) + 8 * j; const float* s = scr + (8 * c8) * 33 + n;
        u32x4 o; o.x = pk2(s[0 * 33], s[1 * 33]); o.y = pk2(s[2 * 33], s[3 * 33]); o.z = pk2(s[4 * 33], s[5 * 33]); o.w = pk2(s[6 * 33], s[7 * 33]);
        *(u32x4*)(dst + (size_t)n * K + k0 + 8 * c8) = o;
    }
    asm volatile("s_waitcnt lgkmcnt(0)" ::: "memory");
}
struct PrepArgs { const float* in[20]; unsigned char* ws; };
constexpr int I_GU = 176 * 16, I_DN = 32 * 44, I_INA = 64 * 16, I_INB = 32 * 16, I_OUT = 32 * 16, I_W1 = 16 * 16;
constexpr int I_TOTAL = 2 * I_GU + 2 * I_DN + I_INA + I_INB + I_OUT + 2 * I_W1;
__device__ __forceinline__ void prep_item(const PrepArgs& a, int it, float* scr, int lane) {
    unsigned char* ws = a.ws;
    int r = it;
    for (int f = 0; f < 2; ++f) {
        if (r < I_GU) {
            const int rb = r / 16, kb = r % 16, dr0 = 32 * rb, pn = dr0 >> 8, within = dr0 & 255;
            const float* W = a.in[(f ? 15 : 2) + (within >= 128 ? 1 : 0)];
            tr_item(W, DFF, DM, 128 * pn + (within & 127), 32, a.in[f ? 14 : 1], (bf16_t*)(ws + (f ? WS_WGU2 : WS_WGU1)) + (size_t)dr0 * DM, 64 * kb, scr, lane);
            return;
        }
        r -= I_GU;
    }
    for (int f = 0; f < 2; ++f) {
        if (r < I_DN) {
            const int rb = r / 44, kb = r % 44;
            tr_item(a.in[f ? 17 : 4], DM, DFF, 32 * rb, 32, nullptr, (bf16_t*)(ws + (f ? WS_WD2 : WS_WD1)) + (size_t)(32 * rb) * DFF, 64 * kb, scr, lane);
            return;
        }
        r -= I_DN;
    }
    if (r < I_INA) {
        const int rb = r / 16, kb = r % 16, dr0 = 32 * rb;
        int col0;
        if (dr0 < 1024) col0 = dr0; else if (dr0 < 1536) col0 = 1536 + (dr0 - 1024); else if (dr0 < 1920) col0 = dr0 + 512; else col0 = 2560 + (dr0 - 1920);
        tr_item(a.in[6], DINP, DM, col0, 32, a.in[5], (bf16_t*)(ws + WS_WINA) + (size_t)dr0 * DM, 64 * kb, scr, lane);
        return;
    }
    r -= I_INA;
    if (r < I_INB) {
        const int rb = r / 16, kb = r % 16, dr0 = 32 * rb;
        int col0, nv = 32;
        if (dr0 < 512) col0 = 1024 + dr0; else if (dr0 < 640) col0 = 2432 + (dr0 - 512); else if (dr0 < 768) col0 = 2688 + (dr0 - 640); else if (dr0 == 768) { col0 = 2816; nv = 24; } else { col0 = 0; nv = 0; }
        tr_item(a.in[6], DINP, DM, col0, nv, a.in[5], (bf16_t*)(ws + WS_WINB) + (size_t)dr0 * DM, 64 * kb, scr, lane);
        return;
    }
    r -= I_INB;
    if (r < I_OUT) {
        const int rb = r / 16, kb = r % 16;
        tr_item(a.in[13], DM, DM, 32 * rb, 32, nullptr, (bf16_t*)(ws + WS_WOUT) + (size_t)(32 * rb) * DM, 64 * kb, scr, lane);
        return;
    }
    r -= I_OUT;
    for (int f = 0; f < 2; ++f) {
        if (r < I_W1) {
            const int rb = r / 16, kb = r % 16, dr0 = 32 * rb, half = dr0 >> 8, j0 = dr0 & 255;
            tr_item(a.in[f ? 11 : 8] + (size_t)half * 1024 * 256, 256, 1024, j0, 32, nullptr, (bf16_t*)(ws + (f ? WS_W1V : WS_W1K)) + (size_t)dr0 * 1024, 64 * kb, scr, lane);
            return;
        }
        r -= I_W1;
    }
}
__global__ void __launch_bounds__(256) k_prep(PrepArgs a) {
    __shared__ float scr_all[4][64 * 33];
    const int wave = threadIdx.x >> 6, lane = threadIdx.x & 63;
    const int gw = blockIdx.x * 4 + wave, ngw = gridDim.x * 4;
    for (int it = gw; it < I_TOTAL; it += ngw) prep_item(a, it, scr_all[wave], lane);
    if (blockIdx.x == gridDim.x - 1) {
        for (int o = threadIdx.x; o < 512; o += 256) {
            const int kv = o >> 8, j = o & 255;
            const float* pos = a.in[kv ? 10 : 7]; const float* w1 = a.in[kv ? 11 : 8];
            float s = 0.f;
            for (int kk = 0; kk < 2048; ++kk) s += pos[kk] * w1[(size_t)kk * 256 + j];
            ((float*)(a.ws + WS_BIAS1))[o] = s;
        }
    }
}

__global__ void __launch_bounds__(256) k_rownorm(const float* x, bf16_t* xb, float* rstd) {
    const int wave = threadIdx.x >> 6, lane = threadIdx.x & 63;
    const int row = blockIdx.x * 4 + wave;
    const f32x4* xr = (const f32x4*)(x + (size_t)row * DM) + lane;
    f32x4 v[4]; float s = 0.f;
#pragma unroll
    for (int j = 0; j < 4; ++j) { v[j] = xr[64 * j]; s += (v[j].x * v[j].x + v[j].y * v[j].y) + (v[j].z * v[j].z + v[j].w * v[j].w); }
    s = wave_sum(s);
    if (lane == 0) rstd[row] = 1.0f / sqrtf(s * (1.0f / DM) + RMS_EPS);
    unsigned long long* o8 = (unsigned long long*)(xb + (size_t)row * DM) + lane;
#pragma unroll
    for (int j = 0; j < 4; ++j) o8[64 * j] = (unsigned long long)pk2(v[j].x, v[j].y) | ((unsigned long long)pk2(v[j].z, v[j].w) << 32);
}
__global__ void __launch_bounds__(256) k_final(float* x, const float* g) {
    const int wave = threadIdx.x >> 6, lane = threadIdx.x & 63;
    const int row = blockIdx.x * 4 + wave;
    f32x4* xr = (f32x4*)(x + (size_t)row * DM) + lane;
    const f32x4* gr = (const f32x4*)g + lane;
    f32x4 v[4]; float s = 0.f;
#pragma unroll
    for (int j = 0; j < 4; ++j) { v[j] = xr[64 * j]; s += (v[j].x * v[j].x + v[j].y * v[j].y) + (v[j].z * v[j].z + v[j].w * v[j].w); }
    s = wave_sum(s);
    const float r = 1.0f / sqrtf(s * (1.0f / DM) + RMS_EPS);
#pragma unroll
    for (int j = 0; j < 4; ++j) xr[64 * j] = v[j] * r * gr[64 * j];
}

struct EpiSwiglu {
    static constexpr bool DUAL = true;
    bf16_t* H; const float* rstd;
    __device__ __forceinline__ void elem2(int row, int hid, float g, float u) const {
        const float r = rstd[row]; g *= r; u *= r;
        const float h = g / (1.0f + __expf(-g)) * u;
        H[(size_t)row * DFF + hid] = (bf16_t)f2bf(h);
    }
};
struct EpiResid {
    static constexpr bool DUAL = false;
    const float* res; float* out; float scale; int pad;
    __device__ __forceinline__ void elem(int row, int col, float v) const { out[(size_t)row * DM + col] = res[(size_t)row * DM + col] + scale * v; }
};
struct EpiProjA {
    static constexpr bool DUAL = false;
    unsigned char* ws; const float* rstd;
    __device__ __forceinline__ void elem(int row, int col, float v) const {
        v *= rstd[row];
        const int b = row >> 12, s = row & 4095, d = col & 63;
        size_t base; int nh, hh;
        if (col < 512) { base = WS_QA; nh = 8; hh = col >> 6; v *= C2; }
        else if (col < 1024) { base = WS_KA; nh = 8; hh = (col - 512) >> 6; }
        else if (col < 1536) { base = WS_QB; nh = 8; hh = (col - 1024) >> 6; v *= C2; }
        else if (col < 1664) { base = WS_KC; nh = 2; hh = (col - 1536) >> 6; }
        else if (col < 1792) { base = WS_VC; nh = 2; hh = (col - 1664) >> 6; }
        else if (col < 1920) { base = WS_KS; nh = 2; hh = (col - 1792) >> 6; }
        else { base = WS_KW; nh = 2; hh = (col - 1920) >> 6; }
        ((bf16_t*)(ws + base))[((size_t)(b * nh + hh) * SEQ + s) * 64 + d] = (bf16_t)f2bf(v);
    }
};
struct EpiProjB {
    static constexpr bool DUAL = false;
    bf16_t* VT; const float* rstd;
    __device__ __forceinline__ void elem(int feat, int tok, float v) const {
        if (feat >= 792) return;
        v *= rstd[tok];
        if (feat >= 768) v = 1.0f / (1.0f + __expf(-v));
        VT[(size_t)feat * MTOK + tok] = (bf16_t)f2bf(v);
    }
};
struct EpiF32 {
    static constexpr bool DUAL = false;
    float* P; int ld; int pad;
    __device__ __forceinline__ void elem(int row, int col, float v) const { P[(size_t)row * ld + col] = v; }
};
template <class Epi>
__global__ void __launch_bounds__(256) k_ngemm(const bf16_t* A, const bf16_t* Bt, int K, int tilesN, Epi E) {
    const int wave = threadIdx.x >> 6, lane = threadIdx.x & 63, r = lane & 31, h = lane >> 5;
    const int tm = blockIdx.x / tilesN, tn = blockIdx.x % tilesN;
    const int i0 = tm * 128 + (wave >> 1) * 64, j0 = tn * 128 + (wave & 1) * 64;
    f32x16 acc[2][2], acc2[2][2];
#pragma unroll
    for (int a = 0; a < 2; ++a)
#pragma unroll
        for (int c = 0; c < 2; ++c) { acc[a][c] = f32x16{}; acc2[a][c] = f32x16{}; }
    const bf16_t* ap[2]; const bf16_t* bp[2];
#pragma unroll
    for (int a = 0; a < 2; ++a) ap[a] = A + (size_t)(i0 + 32 * a + r) * K + 8 * h;
#pragma unroll
    for (int c = 0; c < 2; ++c) { const int j = j0 + 32 * c; const int br = Epi::DUAL ? ((j >> 7) * 256 + (j & 127)) : j; bp[c] = Bt + (size_t)(br + r) * K + 8 * h; }
    for (int k0 = 0; k0 < K; k0 += 16) {
        bf16x8 av[2], bv[2], bv2[2];
#pragma unroll
        for (int a = 0; a < 2; ++a) av[a] = *(const bf16x8*)(ap[a] + k0);
#pragma unroll
        for (int c = 0; c < 2; ++c) { bv[c] = *(const bf16x8*)(bp[c] + k0); if (Epi::DUAL) bv2[c] = *(const bf16x8*)(bp[c] + (size_t)128 * K + k0); }
#pragma unroll
        for (int a = 0; a < 2; ++a)
#pragma unroll
            for (int c = 0; c < 2; ++c) {
                acc[a][c] = __builtin_amdgcn_mfma_f32_32x32x16_bf16(av[a], bv[c], acc[a][c], 0, 0, 0);
                if (Epi::DUAL) acc2[a][c] = __builtin_amdgcn_mfma_f32_32x32x16_bf16(av[a], bv2[c], acc2[a][c], 0, 0, 0);
            }
    }
#pragma unroll
    for (int a = 0; a < 2; ++a)
#pragma unroll
        for (int c = 0; c < 2; ++c)
#pragma unroll
            for (int g = 0; g < 16; ++g) {
                const int i = i0 + 32 * a + crow(g, h), j = j0 + 32 * c + r;
                if constexpr (Epi::DUAL) E.elem2(i, j, acc[a][c][g], acc2[a][c][g]); else E.elem(i, j, acc[a][c][g]);
            }
}

__global__ void __launch_bounds__(256) k_kmean(const bf16_t* KA, float* KMEAN) {
    const int wave = threadIdx.x >> 6, lane = threadIdx.x & 63;
    const int item = blockIdx.x * 4 + wave;
    const int bh = item >> 4, j = item & 15;
    const bf16_t* base = KA + ((size_t)bh * SEQ + 256 * j) * 64;
    const int d8 = lane & 7, rg = lane >> 3;
    float s[8];
#pragma unroll
    for (int e = 0; e < 8; ++e) s[e] = 0.f;
    for (int i = 0; i < 32; ++i) {
        const u32x4 v = *(const u32x4*)(base + (size_t)(rg * 32 + i) * 64 + d8 * 8);
        s[0] += bf2f(v.x & 0xffff); s[1] += bf2f(v.x >> 16); s[2] += bf2f(v.y & 0xffff); s[3] += bf2f(v.y >> 16);
        s[4] += bf2f(v.z & 0xffff); s[5] += bf2f(v.z >> 16); s[6] += bf2f(v.w & 0xffff); s[7] += bf2f(v.w >> 16);
    }
#pragma unroll
    for (int e = 0; e < 8; ++e) { s[e] += __shfl_xor(s[e], 8); s[e] += __shfl_xor(s[e], 16); s[e] += __shfl_xor(s[e], 32); }
    if (rg == 0) {
#pragma unroll
        for (int e = 0; e < 8; ++e) KMEAN[(size_t)item * 64 + d8 * 8 + e] = s[e] * (1.0f / 256.0f);
    }
}

__global__ void __launch_bounds__(256) k_cmp2(const float* PK, const float* PV, const float* bias1, const float* w2k, const float* w2v, bf16_t* KCMP, bf16_t* VCMPT) {
    __shared__ float hid[256];
    const int item = blockIdx.x;
    const int kv = item >> 12, bg = (item >> 8) & 15, n = item & 255, tid = threadIdx.x;
    const float* P = kv ? PV : PK; const float* w2 = kv ? w2v : w2k;
    float hval = 0.f;
    if (n < 255) {
        const float pre = P[(size_t)(bg * 256 + n) * 512 + tid] + P[(size_t)(bg * 256 + n + 1) * 512 + 256 + tid] + bias1[kv * 256 + tid];
        hval = pre / (1.0f + __expf(-pre));
    }
    hid[tid] = hval;
    __syncthreads();
    if (tid < 64) {
        float o = 0.f;
        for (int j = 0; j < 256; ++j) o += hid[j] * w2[j * 64 + tid];
        if (kv == 0) KCMP[((size_t)bg * 256 + n) * 64 + tid] = (bf16_t)f2bf(o);
        else VCMPT[((size_t)bg * 64 + tid) * 256 + n] = (bf16_t)f2bf(o);
    }
}

__device__ __forceinline__ float bflo(unsigned u) { return __builtin_bit_cast(float, u << 16); }
__device__ __forceinline__ float bfhi(unsigned u) { return __builtin_bit_cast(float, u & 0xffff0000u); }
struct Q64 { u32x4 p[8]; };
__device__ __forceinline__ void load_q64(const bf16_t* qrow, Q64& q) {
#pragma unroll
    for (int c = 0; c < 8; ++c) q.p[c] = *(const u32x4*)(qrow + c * 8);
}
__device__ __forceinline__ float dot64(const bf16_t* krow, const Q64& q) {
    float s = 0.f;
#pragma unroll
    for (int c = 0; c < 8; ++c) {
        const u32x4 v = *(const u32x4*)(krow + c * 8); const u32x4 w = q.p[c];
        s += bflo(w.x) * bflo(v.x); s += bfhi(w.x) * bfhi(v.x); s += bflo(w.y) * bflo(v.y); s += bfhi(w.y) * bfhi(v.y);
        s += bflo(w.z) * bflo(v.z); s += bfhi(w.z) * bfhi(v.z); s += bflo(w.w) * bflo(v.w); s += bfhi(w.w) * bfhi(v.w);
    }
    return s;
}
__device__ __forceinline__ float qelem(const Q64& q, int d) {
    const u32x4 w = q.p[d >> 3]; const int e = d & 7;
    const unsigned u = (e >> 1) == 0 ? w.x : (e >> 1) == 1 ? w.y : (e >> 1) == 2 ? w.z : w.w;
    return (e & 1) ? bfhi(u) : bflo(u);
}
__device__ __forceinline__ void acc_v(float (&o)[64], float p, const bf16_t* vt, size_t pitch) {
    const bf16_t* pp = vt;
#pragma unroll
    for (int d = 0; d < 64; ++d) {
        o[d] += p * bf2f(*pp);
        pp += pitch;
        asm volatile("" : "+v"(pp));
    }
}
__device__ __forceinline__ float transpose_reduce(const float (&o)[64], int lane) {
    float res = 0.f;
#pragma unroll
    for (int d = 0; d < 64; ++d) { const float v = wave_sum(o[d]); if (lane == d) res = v; }
    return res;
}

__global__ void __launch_bounds__(256) k_moba_naive(const bf16_t* QA, const bf16_t* KA, const bf16_t* VT, const float* KMEAN, const float* relb, bf16_t* O) {
    const int wave = threadIdx.x >> 6, lane = threadIdx.x & 63;
    const int gw = blockIdx.x * 4 + wave;
    const int t = gw & 4095, bh = gw >> 12, h = bh & 7, b = bh >> 3, cur = t >> 8;
    Q64 q;
    load_q64(QA + (size_t)gw * 64, q);
    float gate = -INFINITY;
    if (lane < cur) {
        const float* km = KMEAN + ((size_t)bh * 16 + lane) * 64;
        float s = 0.f;
#pragma unroll
        for (int d = 0; d < 64; ++d) s += qelem(q, d) * km[d];
        gate = s;
    }
    int rank = 0;
    for (int i = 0; i < 16; ++i) { const float gi = __shfl(gate, i); rank += (gi > gate) || (gi == gate && i < lane); }
    const bool sel = (lane < cur) && (rank < 3);
    unsigned msk = (unsigned)__ballot(sel);
    float sc[16]; int keyb[4];
    const bf16_t* Kh = KA + (size_t)bh * SEQ * 64;
#pragma unroll
    for (int slot = 0; slot < 4; ++slot) {
        bool valid; int j;
        if (slot < 3) { valid = (msk != 0u); j = valid ? (__ffs(msk) - 1) : 0; msk &= msk - 1u; } else { valid = true; j = cur; }
        keyb[slot] = valid ? 256 * j : -1;
#pragma unroll
        for (int kk = 0; kk < 4; ++kk) {
            const int key = 256 * j + 64 * kk + lane, d = t - key;
            float s = -INFINITY;
            if (valid && d >= 0) s = dot64(Kh + (size_t)key * 64, q) + relb[rel_bucket(d) * 16 + h] * LOG2E;
            sc[slot * 4 + kk] = s;
        }
    }
    float m = sc[0];
#pragma unroll
    for (int i = 1; i < 16; ++i) m = fmaxf(m, sc[i]);
    m = wave_max(m);
    float l = 0.f, o[64];
#pragma unroll
    for (int d = 0; d < 64; ++d) o[d] = 0.f;
#pragma unroll
    for (int slot = 0; slot < 4; ++slot)
#pragma unroll
        for (int kk = 0; kk < 4; ++kk) {
            const float p = exp2f(sc[slot * 4 + kk] - m);
            l += p;
            if (keyb[slot] >= 0 && p != 0.f) acc_v(o, p, VT + (size_t)(h * 64) * MTOK + (size_t)b * SEQ + keyb[slot] + 64 * kk + lane, MTOK);
        }
    l = wave_sum(l);
    const float res = transpose_reduce(o, lane) / l;
    O[((size_t)b * SEQ + t) * DM + h * 64 + lane] = (bf16_t)f2bf(res);
}

struct LaneAcc {
    float m, l; float o[64];
    __device__ __forceinline__ void init() {
        m = -INFINITY; l = 0.f;
#pragma unroll
        for (int d = 0; d < 64; ++d) o[d] = 0.f;
    }
    __device__ __forceinline__ void add(float s, const bf16_t* vt, size_t pitch) {
        if (s > -INFINITY) {
            if (s > m) {
                const float alpha = exp2f(m - s);
                l *= alpha;
#pragma unroll
                for (int d = 0; d < 64; ++d) o[d] *= alpha;
                m = s;
            }
            const float p = exp2f(s - m);
            l += p;
            acc_v(o, p, vt, pitch);
        }
    }
    __device__ __forceinline__ float finish(int lane) {
        const float M = wave_max(m);
        if (M == -INFINITY) return 0.f;
        const float sc = (m == -INFINITY) ? 0.f : exp2f(m - M);
        const float L = wave_sum(l * sc);
        float res = 0.f;
#pragma unroll
        for (int d = 0; d < 64; ++d) { const float v = wave_sum(o[d] * sc); if (lane == d) res = v; }
        return res / L;
    }
};

__global__ void __launch_bounds__(64) k_nsa_naive(const bf16_t* QB, const bf16_t* KCMP, const bf16_t* VCMPT, const bf16_t* KS, const bf16_t* KW, const bf16_t* VT, const float* relb, bf16_t* O) {
    const int lane = threadIdx.x & 63;
    const int gw = blockIdx.x;
    const int t = gw & 4095, bhh = gw >> 12, hh = bhh & 7, b = bhh >> 3, g = hh >> 2, bg = b * 2 + g, c = t >> 6;
    float ocmp = 0.f, imp = 0.f;
#pragma unroll 1
    for (int r = 0; r < 4; ++r) {
        const int h2 = 4 * g + r;
        Q64 q;
        load_q64(QB + ((size_t)(b * 8 + h2) * SEQ + t) * 64, q);
        float s[4];
#pragma unroll
        for (int i = 0; i < 4; ++i) {
            const int n = 4 * lane + i, d = t - 16 * n - 31;
            s[i] = -INFINITY;
            if (n <= 254 && d >= 0) s[i] = dot64(KCMP + ((size_t)bg * 256 + n) * 64, q) + relb[rel_bucket(d) * 16 + 8 + h2] * LOG2E;
        }
        float m = wave_max(fmaxf(fmaxf(s[0], s[1]), fmaxf(s[2], s[3])));
        if (m == -INFINITY) m = 0.f;
        float p[4], l = 0.f;
#pragma unroll
        for (int i = 0; i < 4; ++i) { p[i] = exp2f(s[i] - m); l += p[i]; }
        l = wave_sum(l);
        const float linv = l > 0.f ? 1.0f / l : 1.0f;
#pragma unroll
        for (int i = 0; i < 4; ++i) p[i] *= linv;
        float pn = __shfl_down(p[0], 1); if (lane == 63) pn = 0.f;
        imp += p[0] + 2.0f * (p[1] + p[2] + p[3]) + pn;
        if (h2 == hh) {
            float o[64];
#pragma unroll
            for (int d = 0; d < 64; ++d) o[d] = 0.f;
#pragma unroll
            for (int i = 0; i < 4; ++i) if (p[i] != 0.f) acc_v(o, p[i], VCMPT + (size_t)bg * 64 * 256 + 4 * lane + i, 256);
            ocmp = transpose_reduce(o, lane);
        }
    }
    float score;
    if (lane == 0 || lane == c || lane == c - 1) score = INFINITY; else if (lane <= c) score = imp; else score = -INFINITY;
    int rank = 0;
    for (int i = 0; i < 64; ++i) { const float si = __shfl(score, i); rank += (si > score) || (si == score && i < lane); }
    unsigned long long mm = __ballot(rank < 16);
    Q64 q;
    load_q64(QB + (size_t)gw * 64, q);
    const float* rb = relb + 8 + hh;
    const size_t tok0 = (size_t)b * SEQ;
    float result;
    {
        LaneAcc A; A.init();
#pragma unroll 1
        for (int slot = 0; slot < 16; ++slot) {
            const int j = __ffsll((long long)mm) - 1; mm &= mm - 1ull;
            const int key = 64 * j + lane, d = t - key;
            float s = -INFINITY;
            if (d >= 0) s = dot64(KS + ((size_t)bg * SEQ + key) * 64, q) + rb[rel_bucket(d) * 16] * LOG2E;
            A.add(s, VT + (size_t)(512 + g * 64) * MTOK + tok0 + key, MTOK);
        }
        const float g1 = bf2f(VT[(size_t)(768 + hh * 3 + 1) * MTOK + tok0 + t]);
        result = g1 * A.finish(lane);
    }
    {
        LaneAcc A; A.init();
#pragma unroll 1
        for (int i = 0; i < 8; ++i) {
            const int pos = t - 511 + 64 * i + lane;
            float s = -INFINITY;
            if (pos >= 0) s = dot64(KW + ((size_t)bg * SEQ + pos) * 64, q) + rb[rel_bucket(t - pos) * 16] * LOG2E;
            A.add(s, VT + (size_t)(640 + g * 64) * MTOK + tok0 + (pos >= 0 ? pos : 0), MTOK);
        }
        const float g2 = bf2f(VT[(size_t)(768 + hh * 3 + 2) * MTOK + tok0 + t]);
        result += g2 * A.finish(lane);
    }
    const float g0 = bf2f(VT[(size_t)(768 + hh * 3 + 0) * MTOK + tok0 + t]);
    result += g0 * ocmp;
    O[(tok0 + t) * DM + 512 + hh * 64 + lane] = (bf16_t)f2bf(result);
}

extern "C" void kernel_launch(void* const* d_in, const int* in_sizes, int n_in, void* d_out, int out_size, void* d_ws, size_t ws_size, hipStream_t stream) {
    if (n_in != 20 || ws_size < WS_END) { fprintf(stderr, "kernel_launch: unexpected n_in %d / ws_size %zu\n", n_in, ws_size); return; }
    unsigned char* ws = (unsigned char*)d_ws;
    const float* x = (const float*)d_in[0];
    float* out = (float*)d_out;
    bf16_t* XB = (bf16_t*)(ws + WS_XB); bf16_t* H = (bf16_t*)(ws + WS_H); bf16_t* VT = (bf16_t*)(ws + WS_VT); bf16_t* O = (bf16_t*)(ws + WS_O);
    float* RSTD = (float*)(ws + WS_RSTD);
    PrepArgs pa{};
    for (int i = 0; i < 20; ++i) pa.in[i] = (const float*)d_in[i];
    pa.ws = ws;
    k_prep<<<1024, 256, 0, stream>>>(pa);
    k_rownorm<<<MTOK / 4, 256, 0, stream>>>(x, XB, RSTD);
    k_ngemm<EpiSwiglu><<<(MTOK / 128) * (DFF / 128), 256, 0, stream>>>(XB, (const bf16_t*)(ws + WS_WGU1), DM, DFF / 128, EpiSwiglu{H, RSTD});
    k_ngemm<EpiResid><<<(MTOK / 128) * (DM / 128), 256, 0, stream>>>(H, (const bf16_t*)(ws + WS_WD1), DFF, DM / 128, EpiResid{x, out, 0.5f, 0});
    k_rownorm<<<MTOK / 4, 256, 0, stream>>>(out, XB, RSTD);
    k_ngemm<EpiProjA><<<(MTOK / 128) * (2048 / 128), 256, 0, stream>>>(XB, (const bf16_t*)(ws + WS_WINA), DM, 2048 / 128, EpiProjA{ws, RSTD});
    k_ngemm<EpiProjB><<<(1024 / 128) * (MTOK / 128), 256, 0, stream>>>((const bf16_t*)(ws + WS_WINB), XB, DM, MTOK / 128, EpiProjB{VT, RSTD});
    k_kmean<<<(NBATCH * 8 * 16) / 4, 256, 0, stream>>>((const bf16_t*)(ws + WS_KA), (float*)(ws + WS_KMEAN));
    k_ngemm<EpiF32><<<(4096 / 128) * (512 / 128), 256, 0, stream>>>((const bf16_t*)(ws + WS_KC), (const bf16_t*)(ws + WS_W1K), 1024, 512 / 128, EpiF32{(float*)(ws + WS_PK), 512, 0});
    k_ngemm<EpiF32><<<(4096 / 128) * (512 / 128), 256, 0, stream>>>((const bf16_t*)(ws + WS_VC), (const bf16_t*)(ws + WS_W1V), 1024, 512 / 128, EpiF32{(float*)(ws + WS_PV), 512, 0});
    k_cmp2<<<2 * 4096, 256, 0, stream>>>((const float*)(ws + WS_PK), (const float*)(ws + WS_PV), (const float*)(ws + WS_BIAS1), (const float*)d_in[9], (const float*)d_in[12], (bf16_t*)(ws + WS_KCMP), (bf16_t*)(ws + WS_VCMPT));
    k_moba_naive<<<(NBATCH * 8 * SEQ) / 4, 256, 0, stream>>>((const bf16_t*)(ws + WS_QA), (const bf16_t*)(ws + WS_KA), VT, (const float*)(ws + WS_KMEAN), (const float*)d_in[18], O);
    k_nsa_naive<<<NBATCH * 8 * SEQ, 64, 0, stream>>>((const bf16_t*)(ws + WS_QB), (const bf16_t*)(ws + WS_KCMP), (const bf16_t*)(ws + WS_VCMPT), (const bf16_t*)(ws + WS_KS), (const bf16_t*)(ws + WS_KW), VT, (const float*)d_in[18], O);
    k_ngemm<EpiResid><<<(MTOK / 128) * (DM / 128), 256, 0, stream>>>(O, (const bf16_t*)(ws + WS_WOUT), DM, DM / 128, EpiResid{out, out, 1.0f, 0});
    k_rownorm<<<MTOK / 4, 256, 0, stream>>>(out, XB, RSTD);
    k_ngemm<EpiSwiglu><<<(MTOK / 128) * (DFF / 128), 256, 0, stream>>>(XB, (const bf16_t*)(ws + WS_WGU2), DM, DFF / 128, EpiSwiglu{H, RSTD});
    k_ngemm<EpiResid><<<(MTOK / 128) * (DM / 128), 256, 0, stream>>>(H, (const bf16_t*)(ws + WS_WD2), DFF, DM / 128, EpiResid{out, out, 0.5f, 0});
    k_final<<<MTOK / 4, 256, 0, stream>>>(out, (const float*)d_in[19]);
}
```

```cpp
#include <hip/hip_runtime.h>
#include <hip/hip_cooperative_groups.h>
namespace cg = cooperative_groups;
#include <cstdint>
#include <cstdio>

#ifndef STAGGER
#define STAGGER 0
#endif
#ifndef PROBE_GEMM
#define PROBE_GEMM 0
#endif
#ifndef PROBE_ATT
#define PROBE_ATT 0
#endif
typedef unsigned short bf16_t;
typedef short bf16x8 __attribute__((ext_vector_type(8)));
typedef float f32x4 __attribute__((ext_vector_type(4)));
typedef float f32x16 __attribute__((ext_vector_type(16)));
typedef unsigned u32x4 __attribute__((ext_vector_type(4)));

constexpr int MTOK = 32768, DM = 1024, DFF = 2816, SEQ = 4096, NBATCH = 8, DINP = 2840;
constexpr int XLD = 1088;
constexpr float RMS_EPS = 1e-6f;
constexpr float LOG2E = 1.4426950408889634f;
constexpr float C2 = 0.125f * LOG2E;

constexpr size_t MiB = 1u << 20;
constexpr size_t WS_BAR = 0, WS_RSTD = 1 * MiB, WS_KMEAN = 2 * MiB, WS_KCMP = 3 * MiB, WS_VCMPT = 4 * MiB, WS_BIAS1 = 5 * MiB, WS_BLUT = 5 * MiB + 65536, WS_SSPART = 6 * MiB;
constexpr size_t WS_WGU1 = 8 * MiB, WS_WD1 = 19 * MiB, WS_WGU2 = 25 * MiB, WS_WD2 = 36 * MiB, WS_WINA = 42 * MiB, WS_WINB = 46 * MiB, WS_WOUT = 48 * MiB,
                 WS_W1K = 50 * MiB, WS_W1V = 51 * MiB, WS_PK = 52 * MiB, WS_PV = 60 * MiB;
constexpr size_t WS_P = 368 * MiB;
constexpr size_t WS_XB = 72 * MiB, WS_H = 140 * MiB, WS_VT = 316 * MiB, WS_O = 368 * MiB, WS_END = 436 * MiB;
constexpr size_t VT_VA = 0, VT_VS = (size_t)16 * 1024 * 1024, VT_VW = (size_t)20 * 1024 * 1024, VT_G = (size_t)24 * 1024 * 1024;
constexpr size_t WS_QA = WS_H, WS_KA = WS_H + 32 * MiB, WS_QB = WS_H + 64 * MiB, WS_KC = WS_H + 96 * MiB, WS_VC = WS_H + 104 * MiB, WS_KS = WS_H + 112 * MiB, WS_KW = WS_H + 120 * MiB;

__device__ __forceinline__ unsigned f2bf(float f) { unsigned u = __builtin_bit_cast(unsigned, f); return (u + 0x7fffu + ((u >> 16) & 1u)) >> 16; }
__device__ __forceinline__ float bf2f(unsigned short b) { return __builtin_bit_cast(float, (unsigned)b << 16); }
__device__ __forceinline__ unsigned pk2(float lo, float hi) { return f2bf(lo) | (f2bf(hi) << 16); }
template <int K> __device__ __forceinline__ float swz_xor(float v) {
    return __builtin_bit_cast(float, __builtin_amdgcn_ds_swizzle(__builtin_bit_cast(int, v), (K << 10) | 0x1f));
}
__device__ __forceinline__ void swap_x32(float v, float& o0, float& o1) {
    const unsigned a = __builtin_bit_cast(unsigned, v);
    const auto rr = __builtin_amdgcn_permlane32_swap(a, a, false, false);
    unsigned r0 = rr[0], r1 = rr[1];
    asm volatile("" : "+v"(r0), "+v"(r1));
    o0 = __builtin_bit_cast(float, r0); o1 = __builtin_bit_cast(float, r1);
}
__device__ __forceinline__ float sum_x32(float v) { float a, b; swap_x32(v, a, b); return a + b; }
__device__ __forceinline__ float max_x32(float v) { float a, b; swap_x32(v, a, b); return fmaxf(a, b); }
__device__ __forceinline__ float wave_sum(float v) {
    v += swz_xor<1>(v); v += swz_xor<2>(v); v += swz_xor<4>(v); v += swz_xor<8>(v); v += swz_xor<16>(v);
    return sum_x32(v);
}
__device__ __forceinline__ float wave_max(float v) {
    v = fmaxf(v, swz_xor<1>(v)); v = fmaxf(v, swz_xor<2>(v)); v = fmaxf(v, swz_xor<4>(v)); v = fmaxf(v, swz_xor<8>(v)); v = fmaxf(v, swz_xor<16>(v));
    return max_x32(v);
}
__device__ __forceinline__ float lane_read(float v, int src_lane) {
    return __builtin_bit_cast(float, __builtin_amdgcn_ds_bpermute(src_lane << 2, __builtin_bit_cast(int, v)));
}
__device__ __forceinline__ int rel_bucket(int d) {
    if (d < 16) return d;
    return 16 + (d >= 19) + (d >= 21) + (d >= 24) + (d >= 27) + (d >= 31) + (d >= 35) + (d >= 40) + (d >= 46) + (d >= 52) + (d >= 59) + (d >= 67) + (d >= 77) + (d >= 87) + (d >= 99) + (d >= 113);
}
__device__ __forceinline__ int crow(int r, int hi) { return (r & 3) + 8 * (r >> 2) + 4 * hi; }

#define GAS __attribute__((address_space(1)))
#define LAS3 __attribute__((address_space(3)))
struct TrDesc { const float* W; const float* gain; bf16_t* dst; int N, K, col0, nvalid, k0; };
__device__ __forceinline__ void tr_load(const TrDesc& d, f32x4 (&v)[8], int lane) {
#pragma unroll
    for (int i = 0; i < 8; ++i) {
        const int kk = 8 * i + (lane >> 3), c4 = lane & 7;
        v[i] = (f32x4){0.f, 0.f, 0.f, 0.f};
        if (4 * c4 < d.nvalid) { v[i] = *(const GAS f32x4*)(d.W + (size_t)(d.k0 + kk) * d.N + d.col0 + 4 * c4); if (d.gain) v[i] = v[i] * ((const GAS float*)d.gain)[d.k0 + kk]; }
    }
}
__device__ __forceinline__ void tr_finish(const TrDesc& d, const f32x4 (&v)[8], LAS3 float* scr, int lane) {
#pragma unroll
    for (int i = 0; i < 8; ++i) {
        const int kk = 8 * i + (lane >> 3), c4 = lane & 7;
        LAS3 float* s = scr + kk * 33 + 4 * c4;
        s[0] = v[i][0]; s[1] = v[i][1]; s[2] = v[i][2]; s[3] = v[i][3];
    }
    asm volatile("s_waitcnt lgkmcnt(0)" ::: "memory");
    const int c8 = lane & 7;
#pragma unroll
    for (int j = 0; j < 4; ++j) {
        const int n = (lane >> 3) + 8 * j; const LAS3 float* s = scr + (8 * c8) * 33 + n;
        u32x4 o; o.x = pk2(s[0 * 33], s[1 * 33]); o.y = pk2(s[2 * 33], s[3 * 33]); o.z = pk2(s[4 * 33], s[5 * 33]); o.w = pk2(s[6 * 33], s[7 * 33]);
        *(GAS u32x4*)(d.dst + (size_t)n * d.K + d.k0 + 8 * c8) = o;
    }
    asm volatile("s_waitcnt lgkmcnt(0)" ::: "memory");
}
struct MegaArgs { const float* in[20]; float* out; unsigned char* ws; int ph_lo, ph_hi; };
typedef MegaArgs PrepArgs;
constexpr int I_GU = 176 * 16, I_DN = 32 * 44, I_INA = 64 * 16, I_INB = 32 * 16, I_OUT = 32 * 16, I_W1 = 16 * 16;
constexpr int I_TOTAL = 2 * I_GU + 2 * I_DN + I_INA + I_INB + I_OUT + 2 * I_W1;
__device__ __forceinline__ TrDesc prep_desc(const PrepArgs& a, int it) {
    unsigned char* ws = a.ws;
    int r = it;
    for (int f = 0; f < 2; ++f) {
        if (r < I_GU) {
            const int rb = r / 16, kb = r % 16, dr0 = 32 * rb, pn = dr0 >> 8, within = dr0 & 255;
            return TrDesc{a.in[(f ? 15 : 2) + (within >= 128 ? 1 : 0)], a.in[f ? 14 : 1], (bf16_t*)(ws + (f ? WS_WGU2 : WS_WGU1)) + (size_t)dr0 * DM, DFF, DM, 128 * pn + (within & 127), 32, 64 * kb};
        }
        r -= I_GU;
    }
    for (int f = 0; f < 2; ++f) {
        if (r < I_DN) {
            const int rb = r / 44, kb = r % 44;
            return TrDesc{a.in[f ? 17 : 4], nullptr, (bf16_t*)(ws + (f ? WS_WD2 : WS_WD1)) + (size_t)(32 * rb) * DFF, DM, DFF, 32 * rb, 32, 64 * kb};
        }
        r -= I_DN;
    }
    if (r < I_INA) {
        const int rb = r / 16, kb = r % 16, dr0 = 32 * rb;
        int col0;
        if (dr0 < 1024) col0 = dr0; else if (dr0 < 1536) col0 = 1536 + (dr0 - 1024); else if (dr0 < 1920) col0 = dr0 + 512; else col0 = 2560 + (dr0 - 1920);
        return TrDesc{a.in[6], a.in[5], (bf16_t*)(ws + WS_WINA) + (size_t)dr0 * DM, DINP, DM, col0, 32, 64 * kb};
    }
    r -= I_INA;
    if (r < I_INB) {
        const int rb = r / 16, kb = r % 16, dr0 = 32 * rb;
        int col0, nv = 32;
        if (dr0 < 512) col0 = 1024 + dr0; else if (dr0 < 640) col0 = 2432 + (dr0 - 512); else if (dr0 < 768) col0 = 2688 + (dr0 - 640); else if (dr0 == 768) { col0 = 2816; nv = 24; } else { col0 = 0; nv = 0; }
        return TrDesc{a.in[6], a.in[5], (bf16_t*)(ws + WS_WINB) + (size_t)dr0 * DM, DINP, DM, col0, nv, 64 * kb};
    }
    r -= I_INB;
    if (r < I_OUT) {
        const int rb = r / 16, kb = r % 16;
        return TrDesc{a.in[13], nullptr, (bf16_t*)(ws + WS_WOUT) + (size_t)(32 * rb) * DM, DM, DM, 32 * rb, 32, 64 * kb};
    }
    r -= I_OUT;
    const int f = r >= I_W1 ? 1 : 0; r -= f * I_W1;
    const int rb = r / 16, kb = r % 16, dr0 = 32 * rb, half = dr0 >> 8, j0 = dr0 & 255;
    return TrDesc{a.in[f ? 11 : 8] + (size_t)half * 1024 * 256, nullptr, (bf16_t*)(ws + (f ? WS_W1V : WS_W1K)) + (size_t)dr0 * 1024, 256, 1024, j0, 32, 64 * kb};
}
__device__ __forceinline__ void ph_prep(const PrepArgs& a, LAS3 float* scr_wave, int gw, int ngw, int lane) {
    if (gw >= ngw - 128) {
        const int wv4 = gw - (ngw - 128), q4 = wv4 >> 5, wv = wv4 & 31, kv = wv >> 4, j0 = (wv & 15) * 16;
        const float* pos = a.in[kv ? 10 : 7]; const float* w1 = a.in[kv ? 11 : 8];
        f32x4 s[4];
#pragma unroll
        for (int e = 0; e < 4; ++e) s[e] = (f32x4){0.f, 0.f, 0.f, 0.f};
#pragma unroll
        for (int it8 = 0; it8 < 8; ++it8) {
            const int it = q4 * 8 + it8;
            const int kk = it * 64 + lane; const float p = ((const GAS float*)pos)[kk];
#pragma unroll
            for (int e = 0; e < 4; ++e) s[e] += *(const GAS f32x4*)(w1 + (size_t)kk * 256 + j0 + 4 * e) * p;
        }
#pragma unroll
        for (int e = 0; e < 4; ++e)
#pragma unroll
            for (int c = 0; c < 4; ++c) { const float v = wave_sum(s[e][c]); if (lane == 0) ((float*)(a.ws + WS_BIAS1))[q4 * 512 + kv * 256 + j0 + 4 * e + c] = v; }
    }
    if (gw < 112) {
        const int idx = gw * 64 + lane;
        if (idx < 16 * 432) {
            const int hd = idx / 432, j = idx - hd * 432;
            float v;
            if (j >= 304) v = a.in[18][rel_bucket(j - 304) * 16 + hd] * LOG2E;
            else if (j > 207) v = -INFINITY;
            else { const int d = 207 - j; v = a.in[18][rel_bucket(d > 127 ? 127 : d) * 16 + hd] * LOG2E; }
            ((float*)(a.ws + WS_BLUT))[idx] = v;
        }
    }
    if (gw < I_TOTAL) {
        TrDesc d = prep_desc(a, gw); f32x4 v[8];
        tr_load(d, v, lane);
        for (int it = gw; it < I_TOTAL; it += ngw) {
            TrDesc dn = d; f32x4 vn[8];
            const bool more = it + ngw < I_TOTAL;
            if (more) { dn = prep_desc(a, it + ngw); tr_load(dn, vn, lane); }
            tr_finish(d, v, scr_wave, lane);
            if (more) {
                d = dn;
#pragma unroll
                for (int i = 0; i < 8; ++i) v[i] = vn[i];
            }
        }
    }
}

__device__ __forceinline__ void rownorm_row(const float* x, bf16_t* xb, float* sspart, int row, int lane) {
    const f32x4* xr = (const f32x4*)(x + (size_t)row * DM) + lane;
    f32x4 v[4]; float s = 0.f;
#pragma unroll
    for (int j = 0; j < 4; ++j) { v[j] = xr[64 * j]; s += (v[j].x * v[j].x + v[j].y * v[j].y) + (v[j].z * v[j].z + v[j].w * v[j].w); }
    s = wave_sum(s);
    if (lane < 16) sspart[(size_t)row * 16 + lane] = lane == 0 ? s : 0.f;
    unsigned long long* o8 = (unsigned long long*)(xb + (size_t)row * XLD) + lane;
#pragma unroll
    for (int j = 0; j < 4; ++j) o8[64 * j] = (unsigned long long)pk2(v[j].x, v[j].y) | ((unsigned long long)pk2(v[j].z, v[j].w) << 32);
}
__device__ __forceinline__ void rownorm_row2(const float* x, bf16_t* xb, float* sspart, int row0, int row1, int lane) {
    const bool has1 = row1 < MTOK;
    const GAS f32x4* xr0 = (const GAS f32x4*)(x + (size_t)row0 * DM) + lane;
    const GAS f32x4* xr1 = (const GAS f32x4*)(x + (size_t)(has1 ? row1 : row0) * DM) + lane;
    f32x4 v0[4], v1[4]; float s0 = 0.f, s1 = 0.f;
#pragma unroll
    for (int j = 0; j < 4; ++j) { v0[j] = xr0[64 * j]; v1[j] = xr1[64 * j]; }
#pragma unroll
    for (int j = 0; j < 4; ++j) {
        s0 += (v0[j].x * v0[j].x + v0[j].y * v0[j].y) + (v0[j].z * v0[j].z + v0[j].w * v0[j].w);
        s1 += (v1[j].x * v1[j].x + v1[j].y * v1[j].y) + (v1[j].z * v1[j].z + v1[j].w * v1[j].w);
    }
    s0 = wave_sum(s0); s1 = wave_sum(s1);
    if (lane < 16) { ((GAS float*)sspart)[(size_t)row0 * 16 + lane] = lane == 0 ? s0 : 0.f; if (has1) ((GAS float*)sspart)[(size_t)row1 * 16 + lane] = lane == 0 ? s1 : 0.f; }
    GAS unsigned long long* o0 = (GAS unsigned long long*)(xb + (size_t)row0 * XLD) + lane;
    GAS unsigned long long* o1 = (GAS unsigned long long*)(xb + (size_t)row1 * XLD) + lane;
#pragma unroll
    for (int j = 0; j < 4; ++j) {
        o0[64 * j] = (unsigned long long)pk2(v0[j].x, v0[j].y) | ((unsigned long long)pk2(v0[j].z, v0[j].w) << 32);
        if (has1) o1[64 * j] = (unsigned long long)pk2(v1[j].x, v1[j].y) | ((unsigned long long)pk2(v1[j].z, v1[j].w) << 32);
    }
}
__device__ __forceinline__ float final_rstd(const float* sspart, int row, int lane) {
    float s = lane < 16 ? sspart[(size_t)row * 16 + lane] : 0.f;
    s += swz_xor<1>(s); s += swz_xor<2>(s); s += swz_xor<4>(s); s += swz_xor<8>(s);
    s = __builtin_bit_cast(float, __builtin_amdgcn_readfirstlane(__builtin_bit_cast(int, s)));
    return __builtin_amdgcn_rsqf(s * (1.0f / DM) + RMS_EPS);
}
template <int NR>
__device__ __forceinline__ void final_rows(const bf16_t* xb, const float* sspart, float* y, const float* g, const int (&rows)[NR], int lane) {
    u32x4 w[NR][2]; float ss[NR]; f32x4 gv[2][2];
#pragma unroll
    for (int i = 0; i < NR; ++i) {
        const int row = rows[i] < MTOK ? rows[i] : 0;
        ss[i] = lane < 16 ? ((const GAS float*)sspart)[(size_t)row * 16 + lane] : 0.f;
        const GAS u32x4* xr = (const GAS u32x4*)(xb + (size_t)row * XLD) + lane;
        w[i][0] = xr[0]; w[i][1] = xr[64];
    }
#pragma unroll
    for (int j = 0; j < 2; ++j) { gv[j][0] = ((const GAS f32x4*)g)[(64 * j + lane) * 2]; gv[j][1] = ((const GAS f32x4*)g)[(64 * j + lane) * 2 + 1]; }
#pragma unroll
    for (int i = 0; i < NR; ++i) {
        if (rows[i] >= MTOK) continue;
        float s = ss[i];
        s += swz_xor<1>(s); s += swz_xor<2>(s); s += swz_xor<4>(s); s += swz_xor<8>(s);
        s = __builtin_bit_cast(float, __builtin_amdgcn_readfirstlane(__builtin_bit_cast(int, s)));
        const float r = __builtin_amdgcn_rsqf(s * (1.0f / DM) + RMS_EPS);
        GAS f32x4* yr = (GAS f32x4*)(y + (size_t)rows[i] * DM);
#pragma unroll
        for (int j = 0; j < 2; ++j) {
            const u32x4 ww = w[i][j];
            const int c4 = (64 * j + lane) * 2;
            const f32x4 v0 = {__builtin_bit_cast(float, ww.x << 16), __builtin_bit_cast(float, ww.x & 0xffff0000u), __builtin_bit_cast(float, ww.y << 16), __builtin_bit_cast(float, ww.y & 0xffff0000u)};
            const f32x4 v1 = {__builtin_bit_cast(float, ww.z << 16), __builtin_bit_cast(float, ww.z & 0xffff0000u), __builtin_bit_cast(float, ww.w << 16), __builtin_bit_cast(float, ww.w & 0xffff0000u)};
            yr[c4] = v0 * r * gv[j][0]; yr[c4 + 1] = v1 * r * gv[j][1];
        }
    }
}

namespace pg8 {
#define PG8_LAS __attribute__((address_space(3)))
#define PG8_GAS __attribute__((address_space(1)))
typedef unsigned short bf16_t;
typedef short bf16x8 __attribute__((ext_vector_type(8)));
typedef float f32x4 __attribute__((ext_vector_type(4)));
typedef unsigned u32x4 __attribute__((ext_vector_type(4)));
constexpr int BM = 256, BK = 64, HALF = 128, HTB = HALF * BK * 2  , STAGE_BYTES = 8 * HTB, NXCD = 8, WGM = 8;

__host__ __device__ __forceinline__ int lds_byte(int r, int c) { const int st = (r >> 4) * 2 + (c >> 5), rr = r & 15, cc = c & 31, ob = rr * 64 + cc * 2; return st * 1024 + (ob ^ (((ob >> 9) & 1) << 5)); }
__host__ __device__ __forceinline__ void stage_rc(int b, int& R, int& C) { const int st = b / 1024, sb = b % 1024, swz = sb ^ (((sb >> 9) & 1) << 5); R = (st >> 1) * 16 + swz / 64; C = (st & 1) * 32 + (swz % 64) / 2; }
__host__ __device__ __forceinline__ int perm32(int rho) { const int n = rho >> 4, i = rho & 15; return 8 * (i >> 2) + 4 * n + (i & 3); }

struct Unit { int pm, pn; };
struct Gemm { const bf16_t* A; const bf16_t* Bt; int M, N, K; int lda, ldb; };

struct StaticOrder {
    int nM, nN, nwg, G, c; bool rev = false;
    __host__ __device__ void init(int M, int N, int G_, int c_) { nM = M / BM; nN = N / BM; nwg = nM * nN; G = G_; c = c_; }
    __device__ bool next(int i, Unit& u) const {
        const long L = (long)i * G + c; if (L >= nwg) return false;
        int wgid = (int)L; { const int q = nwg / NXCD, r = nwg % NXCD, xcd = wgid % NXCD, off = wgid / NXCD; wgid = (xcd < r ? xcd * (q + 1) : r * (q + 1) + (xcd - r) * q) + off; }
        const int nig = WGM * nN, gid = wgid / nig, fm = gid * WGM, gsz = (nM - fm) < WGM ? (nM - fm) : WGM;
        const int pm_ = fm + ((wgid % nig) % gsz);
        u.pm = __builtin_amdgcn_readfirstlane(rev ? nM - 1 - pm_ : pm_); u.pn = __builtin_amdgcn_readfirstlane((wgid % nig) / gsz); return true;
    }
    __device__ __forceinline__ void a_ready(const Unit&) const {}
    __device__ __forceinline__ void done(const Unit&) const {}
};


#ifndef USE_NT
#define USE_NT 0
#endif
#if USE_NT
#define NT_LD(p) ld_nt(p)
#define NT_ST(p, v) st_nt(p, v)
#else
#define NT_LD(p) (*(const PG8_GAS u32x4*)(p))
#define NT_ST(p, v) (*(PG8_GAS u32x4*)(p) = (v))
#endif
__device__ __forceinline__ u32x4 ld_nt(const u32x4* p) { return __builtin_nontemporal_load(p); }
__device__ __forceinline__ void st_nt(u32x4* p, u32x4 v) { __builtin_nontemporal_store(v, p); }
__device__ __forceinline__ unsigned cvt_pk_bf16(float lo, float hi) { unsigned r; asm volatile("v_cvt_pk_bf16_f32 %0, %1, %2" : "=v"(r) : "v"(lo), "v"(hi)); return r; }
__device__ __forceinline__ u32x4 pack8(const f32x4 a, const f32x4 b) { u32x4 w; w.x = cvt_pk_bf16(a[0], a[1]); w.y = cvt_pk_bf16(a[2], a[3]); w.z = cvt_pk_bf16(b[0], b[1]); w.w = cvt_pk_bf16(b[2], b[3]); return w; }
__device__ __forceinline__ float row_rstd(const float* sspart, int row, int fq) {
    const f32x4 v = *(const PG8_GAS f32x4*)(sspart + (size_t)row * 16 + 4 * fq);
    float s = (v[0] + v[1]) + (v[2] + v[3]);
    s += swz_xor<16>(s); s = sum_x32(s);
    return __builtin_amdgcn_rsqf(s * (1.0f / 1024.0f) + 1e-6f);
}
__device__ __forceinline__ void row_rstd8(float (&rr)[2][4], const float* sspart, int row0, int fq) {
    f32x4 sp[2][4];
#pragma unroll
    for (int ai = 0; ai < 2; ++ai)
#pragma unroll
        for (int m = 0; m < 4; ++m) sp[ai][m] = *(const PG8_GAS f32x4*)(sspart + (size_t)(row0 + ai * HALF + m * 16) * 16 + 4 * fq);
#pragma unroll
    for (int ai = 0; ai < 2; ++ai)
#pragma unroll
        for (int m = 0; m < 4; ++m) {
            const f32x4 v = sp[ai][m];
            float s = (v[0] + v[1]) + (v[2] + v[3]);
            s += swz_xor<16>(s); s = sum_x32(s);
            rr[ai][m] = __builtin_amdgcn_rsqf(s * (1.0f / 1024.0f) + 1e-6f);
        }
}
__device__ __forceinline__ float silu_mul(float g, float u) { return g * __builtin_amdgcn_rcpf(1.0f + __builtin_amdgcn_exp2f(-1.4426950408889634f * g)) * u; }
__device__ __forceinline__ float sigmoid_f(float g) { return __builtin_amdgcn_rcpf(1.0f + __builtin_amdgcn_exp2f(-1.4426950408889634f * g)); }

struct EpiSwigluF {
    static constexpr bool PERM = true, AFTER_DRAIN = false;
    bf16_t* H; const float* sspart;
    __device__ __forceinline__ void operator()(const f32x4 (&acc)[2][2][4][2], const Unit& u, int wr, int wc, int fr, int fq) const {
        const int row0 = u.pm * BM + wr * 64 + fr, col0 = u.pn * 128 + wc * 32 + 8 * fq;
        float rr[2][4];
        row_rstd8(rr, sspart, row0, fq);
#pragma unroll
        for (int ai = 0; ai < 2; ++ai)
#pragma unroll
            for (int m = 0; m < 4; ++m) {
                const int row = row0 + ai * HALF + m * 16;
                const float r = rr[ai][m];
                const float rl = -1.4426950408889634f * r, r2 = r * r;
                f32x4 h[2];
#pragma unroll
                for (int n = 0; n < 2; ++n) {
                    const f32x4 g = acc[ai][0][m][n], uu = acc[ai][1][m][n];
                    f32x4 e = g * rl;
#pragma unroll
                    for (int k = 0; k < 4; ++k) e[k] = __builtin_amdgcn_rcpf(1.0f + __builtin_amdgcn_exp2f(e[k]));
                    h[n] = (g * uu) * (e * r2);
                }
                NT_ST((u32x4*)(H + (size_t)row * 2816 + col0), pack8(h[0], h[1]));
            }
    }
};
struct EpiResidF {
    static constexpr bool PERM = true, AFTER_DRAIN = false;
    const float* res32; bf16_t* xb; float* sspart; float scale; int pad;
    __device__ __forceinline__ void operator()(const f32x4 (&acc)[2][2][4][2], const Unit& u, int wr, int wc, int fr, int fq) const {
        const int row0 = u.pm * BM + wr * 64 + fr, col0 = u.pn * BM + wc * 32 + 8 * fq;
#pragma unroll
        for (int ai = 0; ai < 2; ++ai) {
            f32x4 rs[4][2][2];
            if (pad == 1) {
#pragma unroll
                for (int m = 0; m < 4; ++m)
#pragma unroll
                    for (int bj = 0; bj < 2; ++bj) { rs[m][bj][0] = (f32x4){0.f, 0.f, 0.f, 0.f}; rs[m][bj][1] = (f32x4){0.f, 0.f, 0.f, 0.f}; }
            } else if (res32) {
#pragma unroll
                for (int m = 0; m < 4; ++m)
#pragma unroll
                    for (int bj = 0; bj < 2; ++bj) {
                        const size_t off = (size_t)(row0 + ai * HALF + m * 16) * 1024 + col0 + bj * HALF;
                        rs[m][bj][0] = *(const PG8_GAS f32x4*)(res32 + off); rs[m][bj][1] = *(const PG8_GAS f32x4*)(res32 + off + 4);
                    }
            } else {
                u32x4 rb[4][2];
#pragma unroll
                for (int m = 0; m < 4; ++m)
#pragma unroll
                    for (int bj = 0; bj < 2; ++bj) rb[m][bj] = NT_LD((const u32x4*)(xb + (size_t)(row0 + ai * HALF + m * 16) * XLD + col0 + bj * HALF));
#pragma unroll
                for (int m = 0; m < 4; ++m)
#pragma unroll
                    for (int bj = 0; bj < 2; ++bj) {
                        const u32x4 w = rb[m][bj];
                        rs[m][bj][0] = (f32x4){__builtin_bit_cast(float, w.x << 16), __builtin_bit_cast(float, w.x & 0xffff0000u), __builtin_bit_cast(float, w.y << 16), __builtin_bit_cast(float, w.y & 0xffff0000u)};
                        rs[m][bj][1] = (f32x4){__builtin_bit_cast(float, w.z << 16), __builtin_bit_cast(float, w.z & 0xffff0000u), __builtin_bit_cast(float, w.w << 16), __builtin_bit_cast(float, w.w & 0xffff0000u)};
                    }
            }
#pragma unroll
            for (int m = 0; m < 4; ++m) {
                const int row = row0 + ai * HALF + m * 16;
                const size_t off = (size_t)row * XLD + col0;
                float ss = 0.f;
#pragma unroll
                for (int bj = 0; bj < 2; ++bj) {
                    const f32x4 v0 = rs[m][bj][0] + acc[ai][bj][m][0] * scale, v1 = rs[m][bj][1] + acc[ai][bj][m][1] * scale;
                    ss += (v0[0] * v0[0] + v0[1] * v0[1]) + (v0[2] * v0[2] + v0[3] * v0[3]) + (v1[0] * v1[0] + v1[1] * v1[1]) + (v1[2] * v1[2] + v1[3] * v1[3]);
                    if (pad != 2) NT_ST((u32x4*)(xb + off + bj * HALF), pack8(v0, v1));
                }
                ss += swz_xor<16>(ss); ss = sum_x32(ss);
                if (fq == 0) ((PG8_GAS float*)sspart)[(size_t)row * 16 + u.pn * 4 + wc] = ss;
            }
            asm volatile("" ::: "memory");
        }
    }
};
struct EpiProjAF {
    static constexpr bool PERM = true, AFTER_DRAIN = false;
    unsigned char* ws; const float* sspart;
    __device__ __forceinline__ void operator()(const f32x4 (&acc)[2][2][4][2], const Unit& u, int wr, int wc, int fr, int fq) const {
        const int row0 = u.pm * BM + wr * 64 + fr;
        float rr[2][4];
        row_rstd8(rr, sspart, row0, fq);
#pragma unroll
        for (int bj = 0; bj < 2; ++bj) {
            const int col = u.pn * BM + bj * HALF + wc * 32;
            size_t base; int nh, hh; float sc = 1.0f;
            if (col < 512) { base = WS_QA; nh = 8; hh = col >> 6; sc = C2; }
            else if (col < 1024) { base = WS_KA; nh = 8; hh = (col - 512) >> 6; }
            else if (col < 1536) { base = WS_QB; nh = 8; hh = (col - 1024) >> 6; sc = C2; }
            else if (col < 1664) { base = WS_KC; nh = 2; hh = (col - 1536) >> 6; }
            else if (col < 1792) { base = WS_VC; nh = 2; hh = (col - 1664) >> 6; }
            else if (col < 1920) { base = WS_KS; nh = 2; hh = (col - 1792) >> 6; }
            else { base = WS_KW; nh = 2; hh = (col - 1920) >> 6; }
            bf16_t* T = (bf16_t*)(ws + base);
            const int d0 = (col & 63) + 8 * fq;
#pragma unroll
            for (int ai = 0; ai < 2; ++ai)
#pragma unroll
                for (int m = 0; m < 4; ++m) {
                    const int row = row0 + ai * HALF + m * 16, b = row >> 12, s = row & 4095;
                    const float r = rr[ai][m] * sc;
                    *(PG8_GAS u32x4*)(T + ((size_t)(b * nh + hh) * 4096 + s) * 64 + d0) = pack8(acc[ai][bj][m][0] * r, acc[ai][bj][m][1] * r);
                }
        }
    }
};
struct EpiProjBF {
    static constexpr bool PERM = true, AFTER_DRAIN = false;
    bf16_t* VT; const float* sspart;
    __device__ __forceinline__ void operator()(const f32x4 (&acc)[2][2][4][2], const Unit& u, int wr, int wc, int fr, int fq) const {
        const int lane = fq * 16 + fr;
        const int f0 = u.pm * BM + wr * 64 + fr;
#pragma unroll
        for (int bj = 0; bj < 2; ++bj) {
            const int tokw = u.pn * BM + bj * HALF + wc * 32;
            float rt;
            {
                const float* p = sspart + (size_t)(tokw + (lane & 31)) * 16 + 8 * (lane >> 5);
                const f32x4 a = *(const PG8_GAS f32x4*)p, b = *(const PG8_GAS f32x4*)(p + 4);
                float s = ((a[0] + a[1]) + (a[2] + a[3])) + ((b[0] + b[1]) + (b[2] + b[3]));
                s = sum_x32(s);
                rt = __builtin_amdgcn_rsqf(s * (1.0f / 1024.0f) + 1e-6f);
            }
            f32x4 rs0, rs1;
#pragma unroll
            for (int e = 0; e < 4; ++e) { rs0[e] = lane_read(rt, 8 * fq + e); rs1[e] = lane_read(rt, 8 * fq + 4 + e); }
            const int tok0 = tokw + 8 * fq;
#pragma unroll
            for (int ai = 0; ai < 2; ++ai)
#pragma unroll
                for (int m = 0; m < 4; ++m) {
                    const int fu = u.pm * BM + wr * 64 + ai * HALF + m * 16;
                    const int f = fu + fr;
                    f32x4 v0 = acc[ai][bj][m][0] * rs0, v1 = acc[ai][bj][m][1] * rs1;
                    if (fu >= 768) {
                        if (fu >= 800) continue;
#pragma unroll
                        for (int e = 0; e < 4; ++e) { v0[e] = sigmoid_f(v0[e]); v1[e] = sigmoid_f(v1[e]); }
                        if (f < 792) *(PG8_GAS u32x4*)(VT + VT_G + (size_t)(f - 768) * 32768 + tok0) = pack8(v0, v1);
                    } else {
                        const int bb = tok0 >> 12, tile = (tok0 >> 6) & 63, k0 = tok0 & 63;
                        const size_t base = fu < 512 ? VT_VA : fu < 640 ? VT_VS : VT_VW;
                        const int hx = fu < 512 ? (fu >> 6) : fu < 640 ? ((fu - 512) >> 6) : ((fu - 640) >> 6), nhx = fu < 512 ? 8 : 2;
                        *(PG8_GAS u32x4*)(VT + base + (((size_t)(bb * nhx + hx) * 64 + tile) * 64 + (f & 63)) * 64 + k0) = pack8(v0, v1);
                    }
                }
        }
    }
};
struct EpiNullF {
    static constexpr bool PERM = true, AFTER_DRAIN = false;
    int pad0, pad1;
    __device__ __forceinline__ void operator()(const f32x4 (&acc)[2][2][4][2], const Unit&, int, int, int, int) const {
#pragma unroll
        for (int ai = 0; ai < 2; ++ai)
#pragma unroll
            for (int bj = 0; bj < 2; ++bj)
#pragma unroll
                for (int m = 0; m < 4; ++m) asm volatile("" :: "v"(acc[ai][bj][m][0]), "v"(acc[ai][bj][m][1]));
    }
};
struct EpiF32F {
    static constexpr bool PERM = true, AFTER_DRAIN = false;
    bf16_t* P; int ld; int pad;
    __device__ __forceinline__ void operator()(const f32x4 (&acc)[2][2][4][2], const Unit& u, int wr, int wc, int fr, int fq) const {
        const int row0 = u.pm * BM + wr * 64 + fr, col0 = u.pn * BM + wc * 32 + 8 * fq;
#pragma unroll
        for (int ai = 0; ai < 2; ++ai)
#pragma unroll
            for (int m = 0; m < 4; ++m) { bf16_t* rowp = P + (size_t)(row0 + ai * HALF + m * 16) * ld + col0;
#pragma unroll
                for (int bj = 0; bj < 2; ++bj) *(PG8_GAS u32x4*)(rowp + bj * HALF) = pack8(acc[ai][bj][m][0], acc[ai][bj][m][1]); }
    }
};

template <class Epi, class Sched, bool ALIGN_EPI = false, bool SP2 = false>
__device__ __forceinline__ void gemm_phase(PG8_LAS unsigned char* lds, const Gemm g, const Sched& S, const Epi& E, const int tid) {
    const int wid = __builtin_amdgcn_readfirstlane(tid >> 6), lane = tid & 63, wr = wid >> 2, wc = wid & 3, fr = lane & 15, fq = lane >> 4;
    const int KA_ = g.lda ? g.lda : g.K, KB_ = g.ldb ? g.ldb : g.K, nt = g.K / BK;
    unsigned voffA[2], voffB[2];
#pragma unroll
    for (int i = 0; i < 2; ++i) { int R, C; stage_rc(tid * 16 + i * 8192, R, C); const int Rb = Epi::PERM ? ((R & ~31) + perm32(R & 31)) : R;
        voffA[i] = (unsigned)(R * KA_ + C) * 2u; voffB[i] = (unsigned)(Rb * KB_ + C) * 2u; }
    const size_t kstep = (size_t)(BK * 2);
    const size_t hA = (size_t)HALF * KA_ * 2, hB = (size_t)HALF * KB_ * 2;
    const size_t tA = 2 * hA, tB = 2 * hB;
    const unsigned ldsw = (unsigned)wid * 1024u;
    const int aoff = lds_byte(wr * 64 + fr, fq * 8), boff = lds_byte(wc * 32 + fr, fq * 8);
#define PG8_SA(b, h) (((b) * 2 + (h)) * HTB)
#define PG8_SB(b, h) ((4 + (b) * 2 + (h)) * HTB)
#define PG8_STAGE(bufoff, gbase, voff) do { _Pragma("unroll") for (int _i = 0; _i < 2; ++_i) \
        __builtin_amdgcn_global_load_lds((const unsigned*)((const char*)(gbase) + (voff)[_i]), (PG8_LAS unsigned*)(lds + (bufoff) + ldsw + _i * 8192), 16, 0, 0); } while (0)
#define PG8_LDA(dst, b, h) do { _Pragma("unroll") for (int m = 0; m < 4; ++m) _Pragma("unroll") for (int k = 0; k < 2; ++k) dst[m][k] = *(const PG8_LAS bf16x8*)(lds + PG8_SA(b, h) + aoff + m * 2048 + k * 1024); } while (0)
#define PG8_LDB(dst, b, h) do { _Pragma("unroll") for (int n = 0; n < 2; ++n) _Pragma("unroll") for (int k = 0; k < 2; ++k) dst[n][k] = *(const PG8_LAS bf16x8*)(lds + PG8_SB(b, h) + boff + n * 2048 + k * 1024); } while (0)
#define PG8_MMA(ai, bj, At, Bt) do { __builtin_amdgcn_s_setprio(1); _Pragma("unroll") for (int m = 0; m < 4; ++m) _Pragma("unroll") for (int n = 0; n < 2; ++n) _Pragma("unroll") for (int k = 0; k < 2; ++k) \
        acc[ai][bj][m][n] = __builtin_amdgcn_mfma_f32_16x16x32_bf16(Bt[n][k], At[m][k], acc[ai][bj][m][n], 0, 0, 0); __builtin_amdgcn_s_setprio(0); } while (0)
#define PG8_WAIT_V(n) asm volatile("s_waitcnt vmcnt(" #n ")" ::: "memory")
#define PG8_WAIT_L(n) asm volatile("s_waitcnt lgkmcnt(" #n ")" ::: "memory")
#define PG8_BAR __builtin_amdgcn_s_barrier()
#define PG8_SCHED __builtin_amdgcn_sched_barrier(0)
    Unit cur, nxt; int ui = 0;
    if (!S.next(0, cur)) return;
    f32x4 acc[2][2][4][2];
#pragma unroll
    for (int a = 0; a < 2; ++a)
#pragma unroll
        for (int b = 0; b < 2; ++b)
#pragma unroll
            for (int m = 0; m < 4; ++m)
#pragma unroll
                for (int n = 0; n < 2; ++n) acc[a][b][m][n] = (f32x4){0.f, 0.f, 0.f, 0.f};
    bf16x8 At[4][2], B0[2][2], B1[2][2];
    const char* cA = (const char*)g.A + (size_t)cur.pm * tA; const char* cB = (const char*)g.Bt + (size_t)cur.pn * tB;
    S.a_ready(cur);
    if constexpr (SP2) {
        PG8_STAGE(PG8_SB(0, 0), cB, voffB); PG8_STAGE(PG8_SB(0, 1), cB + hB, voffB); PG8_STAGE(PG8_SA(0, 0), cA, voffA); PG8_STAGE(PG8_SA(0, 1), cA + hA, voffA);
        if (wr == 1) PG8_BAR;
        PG8_WAIT_V(2); PG8_BAR;
        PG8_STAGE(PG8_SB(1, 0), cB + kstep, voffB); PG8_STAGE(PG8_SA(1, 0), cA + kstep, voffA); PG8_STAGE(PG8_SB(1, 1), cB + hB + kstep, voffB);
        PG8_WAIT_V(6); PG8_BAR;
    } else {
        PG8_STAGE(PG8_SB(0, 0), cB, voffB); PG8_STAGE(PG8_SA(0, 0), cA, voffA); PG8_STAGE(PG8_SB(0, 1), cB + hB, voffB); PG8_STAGE(PG8_SA(0, 1), cA + hA, voffA);
        if (wr == 1) PG8_BAR;
        PG8_WAIT_V(4); PG8_BAR;
        PG8_STAGE(PG8_SB(1, 0), cB + kstep, voffB); PG8_STAGE(PG8_SA(1, 0), cA + kstep, voffA); PG8_STAGE(PG8_SB(1, 1), cB + hB + kstep, voffB);
        PG8_WAIT_V(6); PG8_BAR;
    }
    for (;;) {
        const bool has_next = S.next(ui + 1, nxt);
        const char* nA = has_next ? (const char*)g.A + (size_t)nxt.pm * tA : cA; const char* nB = has_next ? (const char*)g.Bt + (size_t)nxt.pn * tB : cB;
        for (int t = 0; t < nt; t += 2) {
            const bool last = (t == nt - 2);
            const char* a1 = cA + (size_t)(t + 1) * kstep;
            const char* a2 = last ? nA : cA + (size_t)(t + 2) * kstep; const char* b2 = last ? nB : cB + (size_t)(t + 2) * kstep;
            const char* a3 = a2 + kstep; const char* b3 = b2 + kstep;
            if (last && has_next) S.a_ready(nxt);
            if constexpr (SP2) {
            PG8_LDB(B0, 0, 0); PG8_LDB(B1, 0, 1); PG8_SCHED; PG8_LDA(At, 0, 0); PG8_STAGE(PG8_SA(1, 1), a1 + hA, voffA);
            PG8_WAIT_V(8); PG8_WAIT_L(0); PG8_BAR; PG8_MMA(0, 0, At, B0); PG8_MMA(0, 1, At, B1); PG8_BAR; PG8_SCHED;
            PG8_LDA(At, 0, 1); PG8_STAGE(PG8_SB(0, 0), b2, voffB); PG8_STAGE(PG8_SB(0, 1), b2 + hB, voffB); PG8_STAGE(PG8_SA(0, 0), a2, voffA);
            PG8_WAIT_V(8); PG8_WAIT_L(0); PG8_BAR; PG8_MMA(1, 0, At, B0); PG8_MMA(1, 1, At, B1); PG8_BAR; PG8_SCHED;
            PG8_LDB(B0, 1, 0); PG8_LDB(B1, 1, 1); PG8_SCHED; PG8_LDA(At, 1, 0); PG8_STAGE(PG8_SA(0, 1), a2 + hA, voffA);
            PG8_WAIT_V(8); PG8_WAIT_L(0); PG8_BAR; PG8_MMA(0, 0, At, B0); PG8_MMA(0, 1, At, B1); PG8_BAR; PG8_SCHED;
            PG8_LDA(At, 1, 1); PG8_STAGE(PG8_SB(1, 0), b3, voffB); PG8_STAGE(PG8_SB(1, 1), b3 + hB, voffB); PG8_STAGE(PG8_SA(1, 0), a3, voffA);
            PG8_WAIT_V(8); PG8_WAIT_L(0); PG8_BAR; PG8_MMA(1, 0, At, B0); PG8_MMA(1, 1, At, B1); PG8_BAR; PG8_SCHED;
            } else {
            PG8_LDB(B0, 0, 0); PG8_SCHED; PG8_LDA(At, 0, 0); PG8_STAGE(PG8_SA(1, 1), a1 + hA, voffA);
            PG8_WAIT_L(8); PG8_BAR; PG8_WAIT_L(0); PG8_MMA(0, 0, At, B0); PG8_BAR; PG8_SCHED;
            PG8_LDB(B1, 0, 1); PG8_STAGE(PG8_SB(0, 0), b2, voffB);
            PG8_BAR; PG8_WAIT_L(0); PG8_MMA(0, 1, At, B1); PG8_BAR;
            PG8_LDA(At, 0, 1); PG8_STAGE(PG8_SA(0, 0), a2, voffA);
            PG8_BAR; PG8_WAIT_L(0); PG8_MMA(1, 0, At, B0); PG8_BAR; PG8_SCHED;
            PG8_STAGE(PG8_SB(0, 1), b2 + hB, voffB);
            PG8_WAIT_V(6); PG8_BAR; PG8_MMA(1, 1, At, B1); PG8_BAR;
            PG8_LDB(B0, 1, 0); PG8_SCHED; PG8_LDA(At, 1, 0); PG8_STAGE(PG8_SA(0, 1), a2 + hA, voffA);
            PG8_WAIT_L(8); PG8_BAR; PG8_WAIT_L(0); PG8_MMA(0, 0, At, B0); PG8_BAR; PG8_SCHED;
            PG8_LDB(B1, 1, 1); PG8_STAGE(PG8_SB(1, 0), b3, voffB);
            PG8_BAR; PG8_WAIT_L(0); PG8_MMA(0, 1, At, B1); PG8_BAR;
            PG8_LDA(At, 1, 1); PG8_STAGE(PG8_SA(1, 0), a3, voffA);
            PG8_BAR; PG8_WAIT_L(0); PG8_MMA(1, 0, At, B0); PG8_BAR; PG8_SCHED;
            PG8_STAGE(PG8_SB(1, 1), b3 + hB, voffB);
            PG8_WAIT_V(6); PG8_BAR; PG8_MMA(1, 1, At, B1); PG8_BAR;
            }
        }
        if constexpr (ALIGN_EPI) { if (wr == 0) PG8_BAR; }
        if constexpr (!Epi::AFTER_DRAIN) {
            unsigned ze_; asm volatile("v_mov_b32 %0, 0" : "=v"(ze_));
            const int le_ = (int)__builtin_amdgcn_mbcnt_hi(~0u, __builtin_amdgcn_mbcnt_lo(~0u, ze_));
            E(acc, cur, wr, wc, le_ & 15, le_ >> 4); S.done(cur);
        }
        if (!has_next) break;
#pragma unroll
        for (int a = 0; a < 2; ++a)
#pragma unroll
            for (int b = 0; b < 2; ++b)
#pragma unroll
                for (int m = 0; m < 4; ++m)
#pragma unroll
                    for (int n = 0; n < 2; ++n) acc[a][b][m][n] = (f32x4){0.f, 0.f, 0.f, 0.f};
        cur = nxt; cA = nA; cB = nB; ++ui;
        if constexpr (ALIGN_EPI) { if (wr == 1) PG8_BAR; }
    }
    PG8_WAIT_V(0);
    if constexpr (!ALIGN_EPI) { if (wr == 0) PG8_BAR; }
    PG8_BAR;
    if constexpr (Epi::AFTER_DRAIN) { E.fused(acc, cur, wr, wc, fr, fq, lds, wid, lane); S.done(cur); }
#undef PG8_SA
#undef PG8_SB
#undef PG8_STAGE
#undef PG8_LDA
#undef PG8_LDB
#undef PG8_MMA
#undef PG8_WAIT_V
#undef PG8_WAIT_L
#undef PG8_BAR
#undef PG8_SCHED
}
}

__device__ __forceinline__ void kmean_item(const bf16_t* KA, float* KMEAN, int item, int lane) {
    const int bh = item >> 4, j = item & 15;
    const bf16_t* base = KA + ((size_t)bh * SEQ + 256 * j) * 64;
    const int d8 = lane & 7, rg = lane >> 3;
    float s[8];
#pragma unroll
    for (int e = 0; e < 8; ++e) s[e] = 0.f;
    for (int i0 = 0; i0 < 32; i0 += 8) {
        u32x4 vv[8];
#pragma unroll
        for (int i = 0; i < 8; ++i) vv[i] = *(const GAS u32x4*)(base + (size_t)(rg * 32 + i0 + i) * 64 + d8 * 8);
#pragma unroll
        for (int i = 0; i < 8; ++i) {
            const u32x4 v = vv[i];
            s[0] += bf2f(v.x & 0xffff); s[1] += bf2f(v.x >> 16); s[2] += bf2f(v.y & 0xffff); s[3] += bf2f(v.y >> 16);
            s[4] += bf2f(v.z & 0xffff); s[5] += bf2f(v.z >> 16); s[6] += bf2f(v.w & 0xffff); s[7] += bf2f(v.w >> 16);
        }
    }
#pragma unroll
    for (int e = 0; e < 8; ++e) { s[e] += swz_xor<8>(s[e]); s[e] += swz_xor<16>(s[e]); s[e] = sum_x32(s[e]); }
    if (rg == 0) {
#pragma unroll
        for (int e = 0; e < 8; ++e) ((GAS float*)KMEAN)[(size_t)item * 64 + d8 * 8 + e] = s[e] * (1.0f / 256.0f);
    }
}

__device__ __forceinline__ void cmp2_group(const float* P  , const float* bias1, const float* w2k, const float* w2v, bf16_t* KCMP, bf16_t* VCMPT, LAS3 float* lds_f, int grp, int tid) {
    const int kv = grp >> 7, bg = (grp >> 3) & 15, n0 = (grp & 7) * 32;
    LAS3 float* hid = lds_f; LAS3 float* w2l = lds_f + 32 * 257 + 3;
    w2l = lds_f + 8232;
    const GAS bf16_t* Pk = (const GAS bf16_t*)P + (size_t)kv * 4 * 4096 * 512; const float* w2 = kv ? w2v : w2k;
    {
        const GAS f32x4* src4 = (const GAS f32x4*)w2; LAS3 f32x4* dst4 = (LAS3 f32x4*)w2l;
#pragma unroll
        for (int i = 0; i < 8; ++i) dst4[tid + 512 * i] = src4[tid + 512 * i];
    }
    {
        const int j = tid & 255, nh = tid >> 8;
        const float bj = (((const GAS float*)bias1)[kv * 256 + j] + ((const GAS float*)bias1)[512 + kv * 256 + j]) + (((const GAS float*)bias1)[1024 + kv * 256 + j] + ((const GAS float*)bias1)[1536 + kv * 256 + j]);
#pragma unroll 1
        for (int ib = 0; ib < 16; ib += 8) {
            unsigned short pv[8][8];
#pragma unroll
            for (int i = 0; i < 8; ++i) {
                const int n = n0 + nh * 16 + ib + i, nc = n < 255 ? n : 254;
#pragma unroll
                for (int sp = 0; sp < 4; ++sp) {
                    pv[i][2 * sp] = Pk[((size_t)sp * 4096 + bg * 256 + nc) * 512 + j];
                    pv[i][2 * sp + 1] = Pk[((size_t)sp * 4096 + bg * 256 + nc + 1) * 512 + 256 + j];
                }
            }
#pragma unroll
            for (int i = 0; i < 8; ++i) {
                const int nn = nh * 16 + ib + i, n = n0 + nn;
                float pre = bj;
#pragma unroll
                for (int sp = 0; sp < 4; ++sp) pre += bf2f(pv[i][2 * sp]) + bf2f(pv[i][2 * sp + 1]);
                const float hval = n < 255 ? pre / (1.0f + __expf(-pre)) : 0.f;
                hid[nn * 257 + j] = hval;
            }
        }
    }
    __syncthreads();
    {
        const int nn = tid >> 4, dg = tid & 15, n = n0 + nn;
        f32x4 o = {0.f, 0.f, 0.f, 0.f};
        const LAS3 float* hr = hid + nn * 257;
#pragma unroll 8
        for (int j = 0; j < 256; ++j) o += *(const LAS3 f32x4*)(w2l + j * 64 + 4 * dg) * hr[j];
        if (kv == 0) {
            *(GAS unsigned long long*)(KCMP + ((size_t)bg * 256 + n) * 64 + 4 * dg) = (unsigned long long)pk2(o[0], o[1]) | ((unsigned long long)pk2(o[2], o[3]) << 32);
        } else {
#pragma unroll
            for (int e = 0; e < 4; ++e) ((GAS bf16_t*)VCMPT)[((size_t)bg * 64 + 4 * dg + e) * 256 + n] = (bf16_t)f2bf(o[e]);
        }
    }
    __syncthreads();
}

__device__ __forceinline__ float bflo(unsigned u) { return __builtin_bit_cast(float, u << 16); }
__device__ __forceinline__ float bfhi(unsigned u) { return __builtin_bit_cast(float, u & 0xffff0000u); }
struct Q64 { u32x4 p[8]; };
__device__ __forceinline__ void load_q64(const bf16_t* qrow, Q64& q) {
#pragma unroll
    for (int c = 0; c < 8; ++c) q.p[c] = *(const __attribute__((address_space(1))) u32x4*)(qrow + c * 8);
}
__device__ __forceinline__ float dot64(const bf16_t* krow, const Q64& q) {
    float s = 0.f;
#pragma unroll
    for (int c = 0; c < 8; ++c) {
        const u32x4 v = *(const u32x4*)(krow + c * 8); const u32x4 w = q.p[c];
        s += bflo(w.x) * bflo(v.x); s += bfhi(w.x) * bfhi(v.x); s += bflo(w.y) * bflo(v.y); s += bfhi(w.y) * bfhi(v.y);
        s += bflo(w.z) * bflo(v.z); s += bfhi(w.z) * bfhi(v.z); s += bflo(w.w) * bflo(v.w); s += bfhi(w.w) * bfhi(v.w);
    }
    return s;
}
__device__ __forceinline__ float qelem(const Q64& q, int d) {
    const u32x4 w = q.p[d >> 3]; const int e = d & 7;
    const unsigned u = (e >> 1) == 0 ? w.x : (e >> 1) == 1 ? w.y : (e >> 1) == 2 ? w.z : w.w;
    return (e & 1) ? bfhi(u) : bflo(u);
}

namespace fa {
#define FA_GAS __attribute__((address_space(1)))
#define FA_LAS __attribute__((address_space(3)))
constexpr int TP = 144;
constexpr int TILE_B = 64 * TP;
constexpr int L_K0 = 0, L_V0 = 4 * TILE_B;
constexpr int L_LUT = 8 * TILE_B;
constexpr int RTN = 304, ELP = RTN + 128;
constexpr int L_KM = L_LUT + 4 * ELP * 4;
constexpr int L_SELT = L_KM + 4096;
constexpr int L_M64 = L_SELT + 2048;
constexpr int L_IMP = L_M64 + 512;
constexpr int L_ACC = L_IMP + 64 * 65 * 4;
constexpr int L_GATE = L_ACC + 6 * 8192;
constexpr int L_END = L_GATE + 4 * 3 * 64 * 2;
static_assert(L_END <= 155648 - 16, "attention LDS map");
constexpr int BIG = 1 << 30;

__device__ __forceinline__ bf16x8 pack8f(float a0, float a1, float a2, float a3, float a4, float a5, float a6, float a7) {
    u32x4 w; w.x = pg8::cvt_pk_bf16(a0, a1); w.y = pg8::cvt_pk_bf16(a2, a3); w.z = pg8::cvt_pk_bf16(a4, a5); w.w = pg8::cvt_pk_bf16(a6, a7);
    return __builtin_bit_cast(bf16x8, w);
}
template <int STRIDE>
__device__ __forceinline__ void tile_scores(f32x16& s0, f32x16& s1, const FA_LAS unsigned char* kb, const bf16x8 (&qf)[4], bool rowok, int t, int pos0, int dlim, bool constpath,
                                            const FA_LAS float* lut, int r, int hi) {
    const int kr = (r & ~12) | ((r & 4) << 1) | ((r & 8) >> 1);
    const FA_LAS unsigned char* ka = kb + kr * TP + hi * 16;
    s0 = f32x16{}; s1 = f32x16{};
#pragma unroll
    for (int s = 0; s < 4; ++s) {
        const bf16x8 a0 = *(const FA_LAS bf16x8*)(ka + s * 32);
        const bf16x8 a1 = *(const FA_LAS bf16x8*)(ka + 32 * TP + s * 32);
        s0 = __builtin_amdgcn_mfma_f32_32x32x16_bf16(a0, qf[s], s0, 0, 0, 0);
        s1 = __builtin_amdgcn_mfma_f32_32x32x16_bf16(a1, qf[s], s1, 0, 0, 0);
    }
    if (constpath) {
        const float add = rowok ? lut[127] : -INFINITY;
#pragma unroll
        for (int g = 0; g < 16; ++g) { s0[g] += add; s1[g] += add; }
    } else {
        const FA_LAS float* rt = lut - RTN;
        const int jb = 207 - (t - pos0 - STRIDE * 8 * hi);
#pragma unroll
        for (int g = 0; g < 16; ++g) {
            const int koff = (g & 7) + 16 * (g >> 3);
            { const int j = jb + STRIDE * koff; s0[g] += rt[j < 0 ? 0 : (j > RTN - 1 ? RTN - 1 : j)]; }
            { const int j = jb + STRIDE * (koff + 32); s1[g] += rt[j < 0 ? 0 : (j > RTN - 1 ? RTN - 1 : j)]; }
        }
    }
}
__device__ __forceinline__ void softmax_pv(f32x16& s0, f32x16& s1, const FA_LAS unsigned char* vb, float& m, float& l, f32x16 (&O)[2], int r, int hi) {
    float mx = fmaxf(s0[0], s1[0]);
#pragma unroll
    for (int g = 1; g < 16; ++g) mx = fmaxf(mx, fmaxf(s0[g], s1[g]));
    mx = max_x32(mx);
    const float mnew = fmaxf(m, mx);
    const float msafe = (mnew == -INFINITY) ? 0.f : mnew;
    const float alpha = __builtin_amdgcn_exp2f(m - msafe);
    m = mnew;
    float sum = 0.f;
#pragma unroll
    for (int g = 0; g < 16; ++g) { s0[g] = __builtin_amdgcn_exp2f(s0[g] - msafe); s1[g] = __builtin_amdgcn_exp2f(s1[g] - msafe); sum += s0[g] + s1[g]; }
    l = l * alpha + sum;
    if (__any(alpha != 1.0f)) { O[0] = O[0] * alpha; O[1] = O[1] * alpha; }
    const FA_LAS unsigned char* va = vb + r * TP + hi * 16;
#pragma unroll
    for (int s2 = 0; s2 < 2; ++s2) {
        const bf16x8 p0 = pack8f(s0[8 * s2 + 0], s0[8 * s2 + 1], s0[8 * s2 + 2], s0[8 * s2 + 3], s0[8 * s2 + 4], s0[8 * s2 + 5], s0[8 * s2 + 6], s0[8 * s2 + 7]);
        const bf16x8 p1 = pack8f(s1[8 * s2 + 0], s1[8 * s2 + 1], s1[8 * s2 + 2], s1[8 * s2 + 3], s1[8 * s2 + 4], s1[8 * s2 + 5], s1[8 * s2 + 6], s1[8 * s2 + 7]);
#pragma unroll
        for (int d0 = 0; d0 < 2; ++d0) {
            const bf16x8 v0 = *(const FA_LAS bf16x8*)(va + d0 * 32 * TP + s2 * 32);
            const bf16x8 v1 = *(const FA_LAS bf16x8*)(va + d0 * 32 * TP + 64 + s2 * 32);
            O[d0] = __builtin_amdgcn_mfma_f32_32x32x16_bf16(v0, p0, O[d0], 0, 0, 0);
            O[d0] = __builtin_amdgcn_mfma_f32_32x32x16_bf16(v1, p1, O[d0], 0, 0, 0);
        }
    }
}
__device__ __forceinline__ void kv_branch(FA_LAS unsigned char* L, const bf16_t* Kbase, const bf16_t* Vbase, int tau0, int tau1, const bf16x8 (&qf)[4], unsigned long long tilemask,
                                          int t, int t_wave0, int dlim, const FA_LAS float* lut, float& m, float& l, f32x16 (&O)[2], int tid, int r, int hi) {
    const int srow = tid >> 3, sch = tid & 7;
    const bf16_t* kp = Kbase + (size_t)tau0 * 4096 + srow * 64 + sch * 8;
    const bf16_t* vp = Vbase + (size_t)tau0 * 4096 + srow * 64 + sch * 8;
    const int soff = srow * TP + sch * 16;
    u32x4 kreg = *(const FA_GAS u32x4*)kp, vreg = *(const FA_GAS u32x4*)vp;
    *(FA_LAS u32x4*)(L + L_K0 + soff) = kreg; *(FA_LAS u32x4*)(L + L_V0 + soff) = vreg;
    __syncthreads();
    int buf = 0;
    for (int tau = tau0; tau <= tau1; ++tau) {
        const bool more = tau < tau1;
        if (more) { kp += 4096; vp += 4096; kreg = *(const FA_GAS u32x4*)kp; vreg = *(const FA_GAS u32x4*)vp; }
        const bool rowok = (tilemask >> tau) & 1ull;
        const int dminw = t_wave0 - (64 * tau + 63), dmaxw = t_wave0 + 31 - 64 * tau;
        if (dmaxw >= 0 && __any(rowok)) {
            f32x16 s0, s1;
            const bool constpath = dminw >= 113 && dmaxw < dlim;
            tile_scores<1>(s0, s1, L + L_K0 + buf * TILE_B, qf, rowok, t, 64 * tau, dlim, constpath, lut, r, hi);
            softmax_pv(s0, s1, L + L_V0 + buf * TILE_B, m, l, O, r, hi);
        }
        if (more) { *(FA_LAS u32x4*)(L + L_K0 + (buf ^ 1) * TILE_B + soff) = kreg; *(FA_LAS u32x4*)(L + L_V0 + (buf ^ 1) * TILE_B + soff) = vreg; }
        __syncthreads();
        buf ^= 1;
    }
}

#define FA_SBAR() __builtin_amdgcn_sched_barrier(0)
#define FA_PIN(x) asm volatile("" : "+v"(x))
#define FA_LD16(p) (*(const FA_LAS bf16x8*)(p))
constexpr float THR = 8.0f;
__device__ __forceinline__ float max3f(float a, float b, float c) { return fmaxf(fmaxf(a, b), c); }

struct BrState {
    float mhat, l;
    bf16x8 kf[4];
    u32x4 kreg, vreg; const bf16_t* kp; const bf16_t* vp;
};
template <bool WIN>
__device__ __forceinline__ void br_step(FA_LAS unsigned char* L, BrState& st, f32x16& c0, f32x16& c1, f32x16& n0, f32x16& n1, f32x16 (&O)[2], const bf16x8 (&qf)[4],
                                        unsigned long long tilemask, int i, int n, int tau, int t, int t_wave0, const FA_LAS float* elut, float cfar, int soff, int kr, int r, int hi) {
    int s_cur = i % 3, s_k2 = (i + 2) % 3, s_k1 = (i + 1) % 3;
    asm volatile("" : "+s"(s_cur), "+s"(s_k2), "+s"(s_k1));
    {
        const int dminw = t_wave0 - (64 * tau + 63), dmaxw = t_wave0 + 31 - 64 * tau;
        const bool far = dminw >= 113 && (!WIN || dmaxw < 512);
        if (!far) {
            if (WIN && dmaxw >= 512) {
                const int db = t - 64 * tau - 8 * hi;
                const float cb = cfar;
#pragma unroll
                for (int g = 0; g < 16; ++g) {
                    const int koff = (g & 7) + 16 * (g >> 3);
                    c0[g] = (db - koff < 512) ? c0[g] + cb : -INFINITY;
                    c1[g] = (db - koff - 32 < 512) ? c1[g] + cb : -INFINITY;
                }
            } else if (dmaxw < 0) {
#pragma unroll
                for (int g = 0; g < 16; ++g) { c0[g] = -INFINITY; c1[g] = -INFINITY; }
            } else {
                const FA_LAS float* rp = elut + (207 - t + 64 * tau + 8 * hi);
                asm volatile("" : "+v"(rp));
#pragma unroll
                for (int gh = 0; gh < 16; gh += 8) {
                    float ta[8], tb[8];
#pragma unroll
                    for (int k = 0; k < 8; ++k) { const int koff = ((gh + k) & 7) + 16 * ((gh + k) >> 3); ta[k] = rp[koff]; tb[k] = rp[koff + 32]; }
                    FA_SBAR();
#pragma unroll
                    for (int k = 0; k < 8; ++k) { c0[gh + k] += ta[k]; c1[gh + k] += tb[k]; }
                    FA_SBAR();
                }
            }
        }
        if (i == 0) {
            float ma = max3f(c0[0], c0[1], c1[0]), mb = max3f(c0[2], c0[3], c1[1]);
            ma = max3f(ma, c1[2], c1[3]);
#pragma unroll
            for (int g = 4; g < 16; g += 4) { ma = max3f(ma, c0[g], c0[g + 1]); mb = max3f(mb, c0[g + 2], c0[g + 3]); ma = max3f(ma, c1[g], c1[g + 1]); mb = max3f(mb, c1[g + 2], c1[g + 3]); }
            float mx = fmaxf(ma, mb);
            mx = max_x32(mx);
            const float delta = mx > -INFINITY ? mx : 0.f;
            st.mhat = delta;
#pragma unroll
            for (int g = 0; g < 16; ++g) { c0[g] -= delta; c1[g] -= delta; }
        }
    }
#if PROBE_ATT == 1
    { float dm = st.mhat; for (int k = 0; k < 32; ++k) { dm = __builtin_amdgcn_exp2f(dm); asm volatile("" : "+v"(dm)); } asm volatile("" :: "v"(dm)); }
#elif PROBE_ATT == 2
    __syncthreads();
#elif PROBE_ATT == 3
    { const FA_LAS unsigned char* pa = L + L_K0 + (r * 2 + hi) * 16; asm volatile("" : "+v"(pa)); _Pragma("unroll") for (int k = 0; k < 16; ++k) { bf16x8 d = FA_LD16(pa + k * 1024); asm volatile("" :: "v"(d)); } }
#endif
#define FA_EXP4(X, B) do { X[B] = __builtin_amdgcn_exp2f(X[B]); X[B + 1] = __builtin_amdgcn_exp2f(X[B + 1]); X[B + 2] = __builtin_amdgcn_exp2f(X[B + 2]); X[B + 3] = __builtin_amdgcn_exp2f(X[B + 3]); FA_PIN(X); } while (0)
    const FA_LAS unsigned char* va = L + L_V0 + s_cur * TILE_B + r * TP + hi * 16;
    asm volatile("" : "+v"(va));
    bf16x8 vf[4];
    {
        f32x16 cin;
        {
            const int tn = tau + 1;
            const int dminw = t_wave0 - (64 * tn + 63), dmaxw = t_wave0 + 31 - 64 * tn;
            const bool far = dminw >= 113 && (!WIN || dmaxw < 512);
            const float cval = ((tilemask >> tn) & 1ull) ? (far ? cfar : 0.f) - st.mhat : -INFINITY;
#pragma unroll
            for (int g = 0; g < 16; ++g) cin[g] = cval;
        }
        const FA_LAS unsigned char* kb = L + L_K0 + s_k1 * TILE_B + kr * TP + hi * 16;
        asm volatile("" : "+v"(kb));
        bf16x8 kg[4];
        FA_SBAR();
#pragma unroll
        for (int j = 0; j < 8; ++j) {
            const int s = j >> 1;
            const bf16x8 kfrag = j < 4 ? st.kf[j] : kg[j - 4];
            if ((j & 1) == 0) n0 = __builtin_amdgcn_mfma_f32_32x32x16_bf16(kfrag, qf[s], s == 0 ? cin : n0, 0, 0, 0);
            else              n1 = __builtin_amdgcn_mfma_f32_32x32x16_bf16(kfrag, qf[s], s == 0 ? cin : n1, 0, 0, 0);
            if (j < 4) FA_EXP4(c0, 4 * j); else FA_EXP4(c1, 4 * (j - 4));
            if (j < 4) kg[j] = FA_LD16(kb + (j & 1) * 32 * TP + ((4 + j) >> 1) * 32);
            else vf[j - 4] = FA_LD16(va + (j & 1) * 32 * TP + ((j - 4) >> 2) * 64 + (((j - 4) >> 1) & 1) * 32);
            FA_SBAR();
        }
    }
#undef FA_EXP4
    {
        const FA_LAS unsigned char* ka = L + L_K0 + s_k2 * TILE_B + kr * TP + hi * 16;
        asm volatile("" : "+v"(ka));
        const bool more2 = i + 2 < n;
        float ls = 0.f;
        bf16x8 pk, vg[4];
        FA_SBAR();
#pragma unroll
        for (int j = 0; j < 8; ++j) {
            const int p = j >> 1, b = 8 * (p & 1);
            const f32x16& S = (p >> 1) ? c1 : c0;
            const bf16x8 vfrag = j < 4 ? vf[j] : vg[j - 4];
            if ((j & 1) == 0) {
                pk = pack8f(S[b], S[b + 1], S[b + 2], S[b + 3], S[b + 4], S[b + 5], S[b + 6], S[b + 7]);
                O[0] = __builtin_amdgcn_mfma_f32_32x32x16_bf16(vfrag, pk, O[0], 0, 0, 0);
                ls += (S[b] + S[b + 1]) + (S[b + 2] + S[b + 3]); FA_PIN(ls);
            } else {
                O[1] = __builtin_amdgcn_mfma_f32_32x32x16_bf16(vfrag, pk, O[1], 0, 0, 0);
                ls += (S[b + 4] + S[b + 5]) + (S[b + 6] + S[b + 7]); FA_PIN(ls);
            }
            if (j < 4) vg[j] = FA_LD16(va + (j & 1) * 32 * TP + ((4 + j) >> 2) * 64 + (((4 + j) >> 1) & 1) * 32);
            else if (more2) st.kf[j - 4] = FA_LD16(ka + (j & 1) * 32 * TP + ((j - 4) >> 1) * 32);
            FA_SBAR();
        }
        st.l += ls;
    }
    if (i + 3 < n) *(FA_LAS u32x4*)(L + L_K0 + s_cur * TILE_B + soff) = st.kreg;
    if (i + 2 < n) *(FA_LAS u32x4*)(L + L_V0 + s_k2 * TILE_B + soff) = st.vreg;
    if (i + 4 < n) { st.kp += 4096; st.kreg = *(const FA_GAS u32x4*)st.kp; }
    if (i + 3 < n) { st.vp += 4096; st.vreg = *(const FA_GAS u32x4*)st.vp; }
    __syncthreads();
}
struct BrPre { u32x4 k0, v0, k1, v1, k2, v2, k3; };
__device__ __forceinline__ void br_preload(BrPre& p, const bf16_t* Kbase, const bf16_t* Vbase, int tau0, int n, int tid) {
    const int srow = tid >> 3, sch = tid & 7;
    const bf16_t* kp = Kbase + (size_t)tau0 * 4096 + srow * 64 + sch * 8;
    const bf16_t* vp = Vbase + (size_t)tau0 * 4096 + srow * 64 + sch * 8;
    p.k0 = *(const FA_GAS u32x4*)kp; p.v0 = *(const FA_GAS u32x4*)vp;
    p.k1 = p.k0; p.v1 = p.v0; p.k2 = p.k0; p.v2 = p.v0; p.k3 = p.k0;
    if (n > 1) { p.k1 = *(const FA_GAS u32x4*)(kp + 4096); p.v1 = *(const FA_GAS u32x4*)(vp + 4096); }
    if (n > 2) { p.k2 = *(const FA_GAS u32x4*)(kp + 2 * 4096); p.v2 = *(const FA_GAS u32x4*)(vp + 2 * 4096); }
    if (n > 3) p.k3 = *(const FA_GAS u32x4*)(kp + 3 * 4096);
}
template <bool WIN, bool PRE = false>
__device__ __forceinline__ void kv_branch2(FA_LAS unsigned char* L, const bf16_t* Kbase, const bf16_t* Vbase, int tau0, int tau1, const bf16x8 (&qf)[4], unsigned long long tilemask,
                                           int t, int t_wave0, const FA_LAS float* elut, float& l, f32x16 (&O)[2], int tid_in, BrPre& pre) {
    int tid = tid_in; asm volatile("" : "+v"(tid));
    const int r = tid & 31, hi = (tid >> 5) & 1;
    const int n = tau1 - tau0 + 1;
    const int srow = tid >> 3, sch = tid & 7, soff = srow * TP + sch * 16;
    const int kr = (r & ~12) | ((r & 4) << 1) | ((r & 8) >> 1);
    const float cfar = __builtin_bit_cast(float, __builtin_amdgcn_readfirstlane(__builtin_bit_cast(int, elut[0])));
    BrState st;
    st.kp = Kbase + (size_t)tau0 * 4096 + srow * 64 + sch * 8;
    st.vp = Vbase + (size_t)tau0 * 4096 + srow * 64 + sch * 8;
    {
        if constexpr (!PRE) br_preload(pre, Kbase, Vbase, tau0, n, tid);
        st.vreg = pre.v2; st.kreg = pre.k3;
        st.kp += (n > 3 ? 3 : n > 2 ? 2 : n > 1 ? 1 : 0) * 4096; st.vp += (n > 2 ? 2 : n > 1 ? 1 : 0) * 4096;
        *(FA_LAS u32x4*)(L + L_K0 + soff) = pre.k0; *(FA_LAS u32x4*)(L + L_V0 + soff) = pre.v0;
        if (n > 1) { *(FA_LAS u32x4*)(L + L_K0 + TILE_B + soff) = pre.k1; *(FA_LAS u32x4*)(L + L_V0 + TILE_B + soff) = pre.v1; }
        if (n > 2) *(FA_LAS u32x4*)(L + L_K0 + 2 * TILE_B + soff) = pre.k2;
    }
    __syncthreads();
    st.mhat = 0.f; st.l = 0.f; O[0] = f32x16{}; O[1] = f32x16{};
    f32x16 A0, A1, B0, B1;
    {
        const int dminw = t_wave0 - (64 * tau0 + 63), dmaxw = t_wave0 + 31 - 64 * tau0;
        const bool far = dminw >= 113 && (!WIN || dmaxw < 512);
        const float cval = ((tilemask >> tau0) & 1ull) ? (far ? cfar : 0.f) : -INFINITY;
        f32x16 cin;
#pragma unroll
        for (int g = 0; g < 16; ++g) cin[g] = cval;
        const FA_LAS unsigned char* ka = L + L_K0 + kr * TP + hi * 16;
        asm volatile("" : "+v"(ka));
#pragma unroll
        for (int s = 0; s < 4; ++s) {
            A0 = __builtin_amdgcn_mfma_f32_32x32x16_bf16(FA_LD16(ka + s * 32), qf[s], s == 0 ? cin : A0, 0, 0, 0);
            A1 = __builtin_amdgcn_mfma_f32_32x32x16_bf16(FA_LD16(ka + 32 * TP + s * 32), qf[s], s == 0 ? cin : A1, 0, 0, 0);
        }
        if (n > 1) {
#pragma unroll
            for (int j = 0; j < 4; ++j) st.kf[j] = FA_LD16(ka + TILE_B + (j & 1) * 32 * TP + (j >> 1) * 32);
        }
    }
    __syncthreads();
    int i = 0;
    for (; i + 1 < n; i += 2) {
        br_step<WIN>(L, st, A0, A1, B0, B1, O, qf, tilemask, i, n, tau0 + i, t, t_wave0, elut, cfar, soff, kr, r, hi);
        br_step<WIN>(L, st, B0, B1, A0, A1, O, qf, tilemask, i + 1, n, tau0 + i + 1, t, t_wave0, elut, cfar, soff, kr, r, hi);
    }
    if (i < n) br_step<WIN>(L, st, A0, A1, B0, B1, O, qf, tilemask, i, n, tau0 + i, t, t_wave0, elut, cfar, soff, kr, r, hi);
    l = st.l;
}

__device__ __forceinline__ void build_lut(FA_LAS float* elut, const float* elutg  , int col0, int nheads, int tid) {
    for (int i = tid; i < nheads * ELP; i += 512) elut[i] = ((const FA_GAS float*)elutg)[col0 * ELP + i];
}
__device__ __forceinline__ void store_ot(const f32x16 (&O)[2], float scale, bf16_t* orow) {
#pragma unroll
    for (int d0 = 0; d0 < 2; ++d0)
#pragma unroll
        for (int gq = 0; gq < 4; ++gq) {
            const unsigned lo = pg8::cvt_pk_bf16(O[d0][4 * gq] * scale, O[d0][4 * gq + 1] * scale), hi2 = pg8::cvt_pk_bf16(O[d0][4 * gq + 2] * scale, O[d0][4 * gq + 3] * scale);
            *(FA_GAS unsigned long long*)(orow + 32 * d0 + 8 * gq) = (unsigned long long)lo | ((unsigned long long)hi2 << 32);
        }
}

__device__ __forceinline__ void moba_unit(unsigned char* ldsg, int b, int h, int cur, const bf16_t* QA, const bf16_t* KA, const bf16_t* VT, const float* KMEAN, const float* relb, bf16_t* Oout, int wave_in) {
    FA_LAS unsigned char* L = (FA_LAS unsigned char*)ldsg;
    unsigned zero_v_; asm volatile("v_mov_b32 %0, 0" : "=v"(zero_v_));
    const int lane = (int)__builtin_amdgcn_mbcnt_hi(~0u, __builtin_amdgcn_mbcnt_lo(~0u, zero_v_)), w = wave_in, r = lane & 31, hi = lane >> 5;
    const int tid = w * 64 + lane;
    const int bh = b * 8 + h;
    FA_LAS float* lut = (FA_LAS float*)(L + L_LUT);
    FA_LAS float* km = (FA_LAS float*)(L + L_KM);
    FA_LAS unsigned long long* selt = (FA_LAS unsigned long long*)(L + L_SELT);
    __syncthreads();
    BrPre pre; br_preload(pre, KA + (size_t)bh * SEQ * 64, VT + VT_VA + (size_t)bh * 64 * 4096, 0, 4 * cur + 4, tid);
    Q64 qq; load_q64(QA + ((size_t)bh * SEQ + 256 * cur + (tid >> 1)) * 64, qq);
    const int tq = 256 * cur + 32 * w + r;
    bf16x8 qf[4];
    {
        const bf16_t* qrow = QA + ((size_t)bh * SEQ + tq) * 64 + 8 * hi;
#pragma unroll
        for (int s = 0; s < 4; ++s) qf[s] = *(const FA_GAS bf16x8*)(qrow + 16 * s);
    }
    build_lut(lut, relb, h, 1, tid);
    { const FA_GAS float* src = (const FA_GAS float*)(KMEAN + (size_t)bh * 1024); km[tid] = src[tid]; km[tid + 512] = src[tid + 512]; }
    __syncthreads();
    {
        const int q = tid >> 1, half = tid & 1;
        FA_LAS float* gsh = (FA_LAS float*)(L + L_V0) + q * 20;
        {
            float qv[64];
#pragma unroll
            for (int d = 0; d < 64; ++d) qv[d] = qelem(qq, d);
#pragma unroll 2
            for (int i = 0; i < 8; ++i) {
                const int j = half * 8 + i;
                float s = -INFINITY;
                if (j < cur) {
                    float s0 = 0.f, s1 = 0.f;
#pragma unroll
                    for (int d = 0; d < 64; d += 4) { const f32x4 kk = *(const FA_LAS f32x4*)(km + j * 64 + d); s0 += qv[d] * kk[0]; s1 += qv[d + 1] * kk[1]; s0 += qv[d + 2] * kk[2]; s1 += qv[d + 3] * kk[3]; }
                    s = s0 + s1;
                }
                gsh[j] = s;
            }
        }
        asm volatile("s_waitcnt lgkmcnt(0)" ::: "memory");
        float ga[16];
#pragma unroll
        for (int j4 = 0; j4 < 4; ++j4) { const f32x4 v = *(const FA_LAS f32x4*)(gsh + 4 * j4); ga[4 * j4] = v[0]; ga[4 * j4 + 1] = v[1]; ga[4 * j4 + 2] = v[2]; ga[4 * j4 + 3] = v[3]; }
        unsigned key[16];
#pragma unroll
        for (int j = 0; j < 16; ++j) { const unsigned u = __builtin_bit_cast(unsigned, ga[j]); const unsigned s = (u & 0x80000000u) ? ~u : (u | 0x80000000u); key[j] = (s & ~15u) | (unsigned)(15 - j); }
        unsigned bits = 0u;
#pragma unroll
        for (int i = 0; i < 8; ++i) {
            unsigned ka_ = key[i], kb_ = key[8 + i]; asm volatile("" : "+v"(ka_), "+v"(kb_));
            const unsigned kj = half ? kb_ : ka_;
            int rank = 0;
#pragma unroll
            for (int i2 = 0; i2 < 16; ++i2) rank += (key[i2] > kj) ? 1 : 0;
            if (half * 8 + i < cur && rank < 3) bits |= 1u << (half * 8 + i);
        }
        bits |= (unsigned)__builtin_amdgcn_ds_swizzle((int)bits, (1 << 10) | 0x1f);
        unsigned long long tm = 0xFull << (4 * cur);
#pragma unroll
        for (int j = 0; j < 16; ++j) if ((bits >> j) & 1u) tm |= 0xFull << (4 * j);
        if (half == 0) selt[q] = tm;
    }
    __syncthreads();
    const unsigned long long tm = selt[32 * w + r];
    float l = 0.f; f32x16 O[2];
    kv_branch2<false, true>(L, KA + (size_t)bh * SEQ * 64, VT + VT_VA + (size_t)bh * 64 * 4096, 0, 4 * cur + 3, qf, tm, tq, 256 * cur + 32 * w, lut, l, O, tid, pre);
    l = sum_x32(l);
    store_ot(O, 1.0f / l, Oout + ((size_t)b * SEQ + tq) * XLD + h * 64 + 4 * hi);
}

__device__ __forceinline__ void nsa_unit(unsigned char* ldsg, int b, int g, int c, const bf16_t* QB, const bf16_t* KCMP, const bf16_t* VCMPT, const bf16_t* KS, const bf16_t* KW, const bf16_t* VT,
                                         const float* relb, bf16_t* Oout, int wave_in) {
    FA_LAS unsigned char* L = (FA_LAS unsigned char*)ldsg;
    unsigned zero_v_; asm volatile("v_mov_b32 %0, 0" : "=v"(zero_v_));
    const int lane = (int)__builtin_amdgcn_mbcnt_hi(~0u, __builtin_amdgcn_mbcnt_lo(~0u, zero_v_)), w = wave_in, r = lane & 31, hi = lane >> 5;
    const int tid = w * 64 + lane;
    const int rh = w >> 1, qh = w & 1, hh = 4 * g + rh, bg = b * 2 + g;
    FA_LAS float* lutall = (FA_LAS float*)(L + L_LUT);
    FA_LAS unsigned* imp = (FA_LAS unsigned*)(L + L_IMP);
    FA_LAS unsigned long long* m64 = (FA_LAS unsigned long long*)(L + L_M64);
    const int nc = (4 * c + 3 + 63) >> 6;
    __syncthreads();
    build_lut(lutall, relb, 8 + 4 * g, 4, tid);
    for (int i = tid; i < 64 * 65; i += 512) imp[i] = 0u;
    if (tid < 96) {
        const int grow = tid >> 3, gch = tid & 7;
        *(FA_LAS u32x4*)(L + L_GATE + grow * 128 + gch * 16) = *(const FA_GAS u32x4*)(VT + VT_G + (size_t)(12 * g + grow) * MTOK + (size_t)b * SEQ + 64 * c + gch * 8);
    }
    {
        const int srow = tid >> 3, sch = tid & 7, soff = srow * TP + sch * 16;
        u32x4 kk[4], vv[4];
#pragma unroll
        for (int tau = 0; tau < 4; ++tau) if (tau < nc) {
            kk[tau] = *(const FA_GAS u32x4*)(KCMP + ((size_t)bg * 256 + 64 * tau + srow) * 64 + sch * 8);
            vv[tau] = *(const FA_GAS u32x4*)(VCMPT + ((size_t)bg * 64 + srow) * 256 + 64 * tau + sch * 8);
        }
#pragma unroll
        for (int tau = 0; tau < 4; ++tau) if (tau < nc) {
            *(FA_LAS u32x4*)(L + L_K0 + tau * TILE_B + soff) = kk[tau];
            *(FA_LAS u32x4*)(L + L_V0 + tau * TILE_B + soff) = vv[tau];
        }
    }
    __syncthreads();
    const int tq = 64 * c + 32 * qh + r, tw0 = 64 * c + 32 * qh;
    const FA_LAS float* elut = lutall + rh * ELP;
    const FA_LAS float* lut = elut + RTN;
    bf16x8 qf[4];
    {
        const bf16_t* qrow = QB + ((size_t)(b * 8 + hh) * SEQ + tq) * 64 + 8 * hi;
#pragma unroll
        for (int s = 0; s < 4; ++s) qf[s] = *(const FA_GAS bf16x8*)(qrow + 16 * s);
    }
#define NSA_FRESH unsigned z2_; asm volatile("v_mov_b32 %0, 0" : "=v"(z2_)); const int lane2 = (int)__builtin_amdgcn_mbcnt_hi(~0u, __builtin_amdgcn_mbcnt_lo(~0u, z2_)); \
    const int tokcol = b * SEQ + 64 * c + 32 * qh + (lane2 & 31); const int hi2 = lane2 >> 5; (void)hi2; \
    FA_LAS f32x4* accp = (FA_LAS f32x4*)(L + (w == 0 ? L_K0 + 3 * TILE_B : w == 1 ? L_V0 + 3 * TILE_B : L_ACC + (w - 2) * 8192)) + lane2; (void)accp; (void)tokcol;
    float l = 0.f; f32x16 O[2];
    {
        f32x16 S[4][2];
#pragma unroll
        for (int tau = 0; tau < 4; ++tau) {
            if (tau < nc && 1024 * tau + 31 <= tw0 + 31) {
                tile_scores<16>(S[tau][0], S[tau][1], L + L_K0 + tau * TILE_B, qf, true, tq, 1024 * tau + 31, BIG, tw0 >= 1024 * tau + 1152  , lut, r, hi);
            } else {
#pragma unroll
                for (int g = 0; g < 16; ++g) { S[tau][0][g] = -INFINITY; S[tau][1][g] = -INFINITY; }
            }
        }
        float mx = -INFINITY;
#pragma unroll
        for (int tau = 0; tau < 4; ++tau)
#pragma unroll
            for (int g = 0; g < 16; ++g) mx = max3f(mx, S[tau][0][g], S[tau][1][g]);
        mx = max_x32(mx);
        const float msafe = (mx == -INFINITY) ? 0.f : mx;
        float sum = 0.f;
#pragma unroll
        for (int tau = 0; tau < 4; ++tau) {
            if (tau < nc) {
#pragma unroll
                for (int g = 0; g < 16; ++g) { S[tau][0][g] = __builtin_amdgcn_exp2f(S[tau][0][g] - msafe); S[tau][1][g] = __builtin_amdgcn_exp2f(S[tau][1][g] - msafe); sum += S[tau][0][g]; FA_PIN(sum); sum += S[tau][1][g]; FA_PIN(sum); }
            }
        }
        const float lt = sum_x32(sum);
        const float inv = lt > 0.f ? 1.0f / lt : 0.f;
        l = lt;
        if (c >= 16) {
            FA_LAS unsigned* improw = imp + (32 * qh + r) * 65;
            float fx = 1048576.0f; asm volatile("" : "+v"(fx));
            const float invf = inv * fx;
#pragma unroll
            for (int tau = 0; tau < 4; ++tau) {
                if (tau < nc) {
#pragma unroll
                    for (int kt = 0; kt < 2; ++kt)
#pragma unroll
                        for (int gq = 0; gq < 4; ++gq) {
                            const f32x16& s = S[tau][kt];
                            float p0 = s[4 * gq] * invf, p1 = s[4 * gq + 1] * invf, p2 = s[4 * gq + 2] * invf, p3 = s[4 * gq + 3] * invf;
                            FA_PIN(p0); FA_PIN(p1); FA_PIN(p2); FA_PIN(p3);
                            const int j = 16 * tau + 8 * kt + (gq & 1) + 2 * hi + 4 * (gq >> 1);
                            const unsigned ua = (unsigned)((p0 + 2.0f * (p1 + p2 + p3)) + 0.5f), ub = (unsigned)(p0 + 0.5f);
                            if (ua) __atomic_fetch_add(improw + j, ua, __ATOMIC_RELAXED);
                            if (ub && j >= 1) __atomic_fetch_add(improw + j - 1, ub, __ATOMIC_RELAXED);
                        }
                }
            }
        }
        O[0] = f32x16{}; O[1] = f32x16{};
#pragma unroll
        for (int tau = 0; tau < 4; ++tau) {
            if (tau < nc) {
                const FA_LAS unsigned char* va = L + L_V0 + tau * TILE_B + r * TP + hi * 16;
#pragma unroll
                for (int s2 = 0; s2 < 2; ++s2) {
                    const f32x16& s0 = S[tau][0]; const f32x16& s1 = S[tau][1];
                    const bf16x8 p0 = pack8f(s0[8 * s2 + 0], s0[8 * s2 + 1], s0[8 * s2 + 2], s0[8 * s2 + 3], s0[8 * s2 + 4], s0[8 * s2 + 5], s0[8 * s2 + 6], s0[8 * s2 + 7]);
                    const bf16x8 p1 = pack8f(s1[8 * s2 + 0], s1[8 * s2 + 1], s1[8 * s2 + 2], s1[8 * s2 + 3], s1[8 * s2 + 4], s1[8 * s2 + 5], s1[8 * s2 + 6], s1[8 * s2 + 7]);
#pragma unroll
                    for (int d0 = 0; d0 < 2; ++d0) {
                        O[d0] = __builtin_amdgcn_mfma_f32_32x32x16_bf16(FA_LD16(va + d0 * 32 * TP + s2 * 32), p0, O[d0], 0, 0, 0);
                        O[d0] = __builtin_amdgcn_mfma_f32_32x32x16_bf16(FA_LD16(va + d0 * 32 * TP + 64 + s2 * 32), p1, O[d0], 0, 0, 0);
                    }
                }
            }
        }
        NSA_FRESH
        const float g0 = bf2f(((const FA_LAS bf16_t*)(L + L_GATE))[(rh * 3 + 0) * 64 + 32 * qh + (lane2 & 31)]);
        const float sc0 = g0 * inv;
        O[0] = O[0] * sc0; O[1] = O[1] * sc0;
    }
    BrPre pre; br_preload(pre, KS + (size_t)bg * SEQ * 64, VT + VT_VS + (size_t)bg * 64 * 4096, 0, c + 1, tid);
    __syncthreads();
    { NSA_FRESH
#pragma unroll
    for (int k4 = 0; k4 < 4; ++k4) { accp[k4 * 64] = (f32x4){O[0][4 * k4], O[0][4 * k4 + 1], O[0][4 * k4 + 2], O[0][4 * k4 + 3]}; accp[(4 + k4) * 64] = (f32x4){O[1][4 * k4], O[1][4 * k4 + 1], O[1][4 * k4 + 2], O[1][4 * k4 + 3]}; } }
    if (c >= 16) {
        const int q = tid >> 3, jj = tid & 7;
        const FA_LAS unsigned* row = imp + q * 65;
        FA_LAS unsigned* roww = imp + q * 65;
        unsigned sc[8]; int rank[8];
#pragma unroll
        for (int i = 0; i < 8; ++i) {
            const int j = jj * 8 + i;
            const unsigned v = (j == 0 || j == c || j == c - 1) ? 0xFFFFFFC0u : (roww[j] << 6);
            sc[i] = v | (unsigned)(63 - j); rank[i] = 0;
            roww[j] = sc[i];
        }
        asm volatile("s_waitcnt lgkmcnt(0)" ::: "memory");
        for (int i2 = 0; i2 <= c; ++i2) {
            const unsigned v = row[i2];
#pragma unroll
            for (int i = 0; i < 8; ++i) rank[i] += (v > sc[i]) ? 1 : 0;
        }
        unsigned bits = 0u;
#pragma unroll
        for (int i = 0; i < 8; ++i) if (jj * 8 + i <= c && rank[i] < 16) bits |= 1u << i;
        ((FA_LAS unsigned char*)m64)[q * 8 + jj] = (unsigned char)bits;
    } else if (tid < 64) {
        m64[tid] = (2ull << c) - 1ull;
    }
    __syncthreads();
    const unsigned long long tm = m64[32 * qh + r];
    kv_branch2<false, true>(L, KS + (size_t)bg * SEQ * 64, VT + VT_VS + (size_t)bg * 64 * 4096, 0, c, qf, tm, tq, tw0, elut, l, O, tid, pre);
    br_preload(pre, KW + (size_t)bg * SEQ * 64, VT + VT_VW + (size_t)bg * 64 * 4096, c >= 8 ? c - 8 : 0, c >= 8 ? 9 : c + 1, tid);
    {
        const float lt = sum_x32(l);
        NSA_FRESH
        const float g1 = bf2f(((const FA_LAS bf16_t*)(L + L_GATE))[(rh * 3 + 1) * 64 + 32 * qh + (lane2 & 31)]);
        const float sc = g1 / lt;
#pragma unroll
        for (int k4 = 0; k4 < 4; ++k4) {
            f32x4 a0 = accp[k4 * 64], a1 = accp[(4 + k4) * 64];
#pragma unroll
            for (int e = 0; e < 4; ++e) { a0[e] += O[0][4 * k4 + e] * sc; a1[e] += O[1][4 * k4 + e] * sc; }
            accp[k4 * 64] = a0; accp[(4 + k4) * 64] = a1;
        }
    }
    kv_branch2<true, true>(L, KW + (size_t)bg * SEQ * 64, VT + VT_VW + (size_t)bg * 64 * 4096, c >= 8 ? c - 8 : 0, c, qf, ~0ull, tq, tw0, elut, l, O, tid, pre);
    {
        const float lt = sum_x32(l);
        NSA_FRESH
        const float g2 = bf2f(((const FA_LAS bf16_t*)(L + L_GATE))[(rh * 3 + 2) * 64 + 32 * qh + (lane2 & 31)]);
        const float sc = g2 / lt;
#pragma unroll
        for (int k4 = 0; k4 < 4; ++k4) {
            const f32x4 a0 = accp[k4 * 64], a1 = accp[(4 + k4) * 64];
#pragma unroll
            for (int e = 0; e < 4; ++e) { O[0][4 * k4 + e] = a0[e] + O[0][4 * k4 + e] * sc; O[1][4 * k4 + e] = a1[e] + O[1][4 * k4 + e] * sc; }
        }
        store_ot(O, 1.0f, Oout + (size_t)tokcol * XLD + 512 + hh * 64 + 4 * hi2);
    }
#undef NSA_FRESH
}
}

#define XB_TMO      128
#define XB_XCNT(j)  (256  + 64 * (j))
#define XB_XSUB(j)  (1280 + 64 * (j))
#define XB_XGEN(j)  (2304 + 64 * (j))
#define XB_TOP      3328
#define XB_TOPGEN   3392
#define XB_DONE     3456
#define XCD_BAR_WORDS 3520
#define XB_SPIN_CAP (1u << 18)

__device__ __forceinline__ unsigned xb_ld(unsigned* p)              { return __hip_atomic_load(p, __ATOMIC_RELAXED, __HIP_MEMORY_SCOPE_AGENT); }
__device__ __forceinline__ unsigned xb_add(unsigned* p, unsigned v) { return __hip_atomic_fetch_add(p, v, __ATOMIC_RELAXED, __HIP_MEMORY_SCOPE_AGENT); }
__device__ __forceinline__ unsigned xb_xcc_id() { return (unsigned)__builtin_amdgcn_s_getreg((3 << 11) | 20) & 0xFu; }
#define XB_SPIN(cond, bar) do { unsigned _sp = 0; while (cond) { __builtin_amdgcn_s_sleep(1); \
    if ((++_sp & 255u) == 0u) { if (xb_ld(&(bar)[XB_TMO])) break; if (_sp > XB_SPIN_CAP) { atomicAdd(&(bar)[XB_TMO], 1u); break; } } } } while (0)

struct XcdBarrier {
    unsigned* bar; unsigned x;
    volatile __attribute__((address_space(3))) unsigned* st;
};

__device__ __forceinline__ XcdBarrier xcd_barrier_post(unsigned* bar, volatile __attribute__((address_space(3))) unsigned* st) {
    XcdBarrier b; b.bar = bar; b.x = xb_xcc_id(); b.st = st;
    if (threadIdx.x == 0) (void)xb_add(&bar[XB_XCNT(b.x)], 1u);
    return b;
}
__device__ __forceinline__ void xcd_barrier_complete(unsigned* bar, unsigned x, unsigned& nloc, unsigned& nx) {
    const unsigned G = gridDim.x * gridDim.y * gridDim.z;
    unsigned sum, cnt, mine, sp = 0u;
    for (;;) {
        sum = 0u; cnt = 0u; mine = 0u;
#pragma unroll
        for (unsigned j = 0; j < 16; ++j) { const unsigned c = xb_ld(&bar[XB_XCNT(j)]); sum += c; cnt += (c > 0u) ? 1u : 0u; mine = (j == x) ? c : mine; }
        if (sum == G) break;
        __builtin_amdgcn_s_sleep(1);
        if ((++sp & 255u) == 0u) { if (xb_ld(&bar[XB_TMO])) break; if (sp > XB_SPIN_CAP) { atomicAdd(&bar[XB_TMO], 1u); break; } }
    }
    nloc = mine > 0u ? mine : 1u; nx = cnt > 0u ? cnt : 1u;
}

__device__ __forceinline__ void xcd_barrier(const XcdBarrier& b) {
    asm volatile("s_waitcnt vmcnt(0)" ::: "memory");
    __syncthreads();
    if (threadIdx.x == 0) {
        unsigned* bar = b.bar;
        __builtin_amdgcn_s_waitcnt(0);
        unsigned nloc = b.st[0], nx = b.st[1];
        if (nloc == 0u) { xcd_barrier_complete(bar, b.x, nloc, nx); b.st[0] = nloc; b.st[1] = nx; }
        const unsigned old = xb_add(&bar[XB_XSUB(b.x)], 1u);
        const unsigned gen = old / nloc;
        if (old + 1u == (gen + 1u) * nloc) {
            __builtin_amdgcn_fence(__ATOMIC_RELEASE, "agent");
            asm volatile("s_waitcnt vmcnt(0)" ::: "memory");
            const unsigned og = xb_add(&bar[XB_TOP], 1u);
            const unsigned tg = og / nx;
            if (og + 1u == (tg + 1u) * nx) xb_add(&bar[XB_TOPGEN], 1u);
            else XB_SPIN(xb_ld(&bar[XB_TOPGEN]) == tg, bar);
            __builtin_amdgcn_fence(__ATOMIC_ACQUIRE, "agent");
            xb_add(&bar[XB_XGEN(b.x)], 1u);
            asm volatile("s_waitcnt vmcnt(0)" ::: "memory");
        } else {
            XB_SPIN(xb_ld(&bar[XB_XGEN(b.x)]) == gen, bar);
            __builtin_amdgcn_fence(__ATOMIC_ACQUIRE, "agent");
            asm volatile("s_waitcnt vmcnt(0)" ::: "memory");
        }
    }
    __syncthreads();
}

#ifndef PROBE_REPEAT
#define PROBE_REPEAT (-1)
#endif
#ifndef PROBE_EMPTY
#define PROBE_EMPTY 0
#endif
constexpr int NPHASE = 11 + (PROBE_REPEAT >= 0 ? 1 : 0) + PROBE_EMPTY;
constexpr int LDS_BYTES = 155648;

__global__ void __launch_bounds__(512, 2) mega(MegaArgs a) {
    extern __shared__ __attribute__((aligned(16))) unsigned char lds[];
    unsigned char* ws = a.ws; float* out = a.out;
    const int G_s = (int)gridDim.x;
    const int wave_s = __builtin_amdgcn_readfirstlane((int)threadIdx.x >> 6);
    volatile __attribute__((address_space(3))) unsigned* bar_st = (volatile __attribute__((address_space(3))) unsigned*)((__attribute__((address_space(3))) unsigned char*)lds + (LDS_BYTES - 16));
    if (threadIdx.x < 2) bar_st[threadIdx.x] = 0u;
    __syncthreads();
    (void)xcd_barrier_post((unsigned*)(a.ws + WS_BAR), bar_st);
    for (int ph0 = a.ph_lo; ph0 < a.ph_hi; ++ph0) {
        const int ph = (PROBE_REPEAT >= 0 && ph0 > PROBE_REPEAT) ? ph0 - 1 : ph0;
        int wave = wave_s, G = G_s, bx = (int)blockIdx.x; asm volatile("" : "+s"(wave), "+s"(ws), "+s"(out), "+s"(G), "+s"(bx));
        const int gw = bx * 8 + wave, ngw = G * 8;
#define LANE_TID unsigned zero_v_; asm volatile("v_mov_b32 %0, 0" : "=v"(zero_v_)); const int lane = (int)__builtin_amdgcn_mbcnt_hi(~0u, __builtin_amdgcn_mbcnt_lo(~0u, zero_v_)); const int tid = wave * 64 + lane; (void)tid;
        bf16_t* XB = (bf16_t*)(ws + WS_XB); bf16_t* H = (bf16_t*)(ws + WS_H); bf16_t* VT = (bf16_t*)(ws + WS_VT); bf16_t* O = (bf16_t*)(ws + WS_O);
        float* SSP = (float*)(ws + WS_SSPART);
        PG8_LAS unsigned char* glds = (PG8_LAS unsigned char*)lds;
        if (ph == 0) {
            LANE_TID
            ph_prep(a, (LAS3 float*)lds + wave * (64 * 33), gw, ngw, lane);
            for (int row = gw; row < MTOK; row += 2 * ngw) rownorm_row2(a.in[0], XB, SSP, row, row + ngw, lane);
        } else if (ph == 1 || ph == 8) {
            LANE_TID
            pg8::Gemm g{XB, (const bf16_t*)(ws + (ph == 1 ? WS_WGU1 : WS_WGU2)), MTOK, 2 * DFF, DM, XLD, 0};
            pg8::StaticOrder S; S.init(MTOK, 2 * DFF, G, bx);
            pg8::EpiSwigluF E{H, SSP};
#if STAGGER
            for (int k = 0; k < (bx & 7); ++k) __builtin_amdgcn_s_sleep(75);
#endif
            pg8::gemm_phase<pg8::EpiSwigluF, pg8::StaticOrder, true, true>(glds, g, S, E, tid);
#if PROBE_GEMM == 1
            if (ph == 1) { pg8::EpiNullF EN{0, 0}; pg8::gemm_phase<pg8::EpiNullF, pg8::StaticOrder, true, true>(glds, g, S, EN, tid); }
#elif PROBE_GEMM == 3
            if (ph == 1) { pg8::Gemm g2{H, (const bf16_t*)(ws + WS_WD1), MTOK, DM, DFF, 0, 0}; pg8::StaticOrder S2; S2.init(MTOK, DM, G, bx); pg8::EpiResidF E2{nullptr, (bf16_t*)(ws + WS_O), (float*)(ws + WS_VT), 0.5f, 0}; pg8::gemm_phase<pg8::EpiResidF, pg8::StaticOrder, true, true>(glds, g2, S2, E2, tid); }
#elif PROBE_GEMM == 4 || PROBE_GEMM == 5
            if (ph == 1) { pg8::Gemm g2{H, (const bf16_t*)(ws + WS_WD1), MTOK, DM, DFF, 0, 0}; pg8::StaticOrder S2; S2.init(MTOK, DM, G, bx); pg8::EpiResidF E2{nullptr, (bf16_t*)(ws + WS_O), (float*)(ws + WS_VT), 0.5f, PROBE_GEMM == 4 ? 1 : 2}; pg8::gemm_phase<pg8::EpiResidF, pg8::StaticOrder, true, true>(glds, g2, S2, E2, tid); }
#elif PROBE_GEMM == 2
            if (ph == 1) { pg8::Gemm g2{H, (const bf16_t*)(ws + WS_WD1), MTOK, DM, DFF, 0, 0}; pg8::StaticOrder S2; S2.init(MTOK, DM, G, bx); pg8::EpiNullF EN{0, 0}; pg8::gemm_phase<pg8::EpiNullF, pg8::StaticOrder, true, true>(glds, g2, S2, EN, tid); }
#endif
        } else if (ph == 2 || ph == 7 || ph == 9) {
            LANE_TID
            pg8::Gemm g{ph == 7 ? O : H, (const bf16_t*)(ws + (ph == 2 ? WS_WD1 : ph == 7 ? WS_WOUT : WS_WD2)), MTOK, DM, ph == 7 ? DM : DFF, ph == 7 ? XLD : 0, 0};
            pg8::StaticOrder S; S.init(MTOK, DM, G, bx);
            pg8::EpiResidF E{nullptr, XB, SSP, ph == 7 ? 1.0f : 0.5f, 0};
            pg8::gemm_phase<pg8::EpiResidF, pg8::StaticOrder, true, true>(glds, g, S, E, tid);
        } else if (ph == 3) {
            LANE_TID
            {
                pg8::Gemm g{XB, (const bf16_t*)(ws + WS_WINA), MTOK, 2048, DM, XLD, 0};
                pg8::StaticOrder S; S.init(MTOK, 2048, G, bx);
                pg8::EpiProjAF E{ws, SSP};
                pg8::gemm_phase<pg8::EpiProjAF, pg8::StaticOrder, true, true>(glds, g, S, E, tid);
            }
            {
                pg8::Gemm g{(const bf16_t*)(ws + WS_WINB), XB, 1024, MTOK, DM, 0, XLD};
                pg8::StaticOrder S; S.init(1024, MTOK, G, bx);
                pg8::EpiProjBF E{VT, SSP};
                pg8::gemm_phase<pg8::EpiProjBF, pg8::StaticOrder, true, true>(glds, g, S, E, tid);
            }
        } else if (ph == 4) {
            LANE_TID
            if ((gw & 1) == 0) for (int it = gw >> 1; it < NBATCH * 8 * 16; it += ngw >> 1) kmean_item((const bf16_t*)(ws + WS_KA), (float*)(ws + WS_KMEAN), it, lane);
            {
                const int q = (bx >> 5) & 7, kv = q >> 2, sp = q & 3;
                pg8::Gemm g{(const bf16_t*)(ws + (kv ? WS_VC : WS_KC)) + 256 * sp, (const bf16_t*)(ws + (kv ? WS_W1V : WS_W1K)) + 256 * sp, 4096, 512, 256, 1024, 1024};
                pg8::StaticOrder S; S.init(4096, 512, G, bx & 31);
                pg8::EpiF32F E{(bf16_t*)(ws + WS_P) + (size_t)q * 4096 * 512, 512, 0};
                pg8::gemm_phase<pg8::EpiF32F, pg8::StaticOrder, true, true>(glds, g, S, E, tid);
            }
        } else if (ph == 5) {
            LANE_TID
            for (int grp = bx; grp < 256; grp += G)
                cmp2_group((const float*)(ws + WS_P), (const float*)(ws + WS_BIAS1), a.in[9], a.in[12], (bf16_t*)(ws + WS_KCMP), (bf16_t*)(ws + WS_VCMPT), (LAS3 float*)lds, grp, tid);
        } else if (ph == 6) {
            LANE_TID
            for (int k = 0; k * G < 1024; ++k) {
                int idx = k * G + ((k & 1) ? G - 1 - bx : bx);
                if (G == 256) {
                    const int x = bx & 7, jl = bx >> 3, bhx = 8 * x + 2 * k + (jl >> 4), curx = (k & 1) ? (jl & 15) : 15 - (jl & 15);
                    idx = ((15 - curx) << 6) | bhx;
                }
                if (idx < 1024) fa::moba_unit(lds, (idx & 63) >> 3, idx & 7, 15 - (idx >> 6), (const bf16_t*)(ws + WS_QA), (const bf16_t*)(ws + WS_KA), VT, (const float*)(ws + WS_KMEAN), (const float*)(ws + WS_BLUT), O, wave);
            }
#ifndef PROBE_NSA
#define PROBE_NSA 0
#endif
            for (int rep_ = 0; rep_ <= PROBE_NSA; ++rep_)
            for (int k = 0; k * G < 1024; ++k) {
                int idx = k * G + ((k & 1) ? G - 1 - bx : bx);
                if (G == 256) {
                    const int x = bx & 7, jl = bx >> 3, bgx = 2 * x + (k >> 1), cx = (k & 1) ? jl : 63 - jl;
                    idx = ((63 - cx) << 4) | bgx;
                }
                if (idx < 1024) fa::nsa_unit(lds, (idx & 15) >> 1, idx & 1, 63 - (idx >> 4), (const bf16_t*)(ws + WS_QB), (const bf16_t*)(ws + WS_KCMP), (const bf16_t*)(ws + WS_VCMPT), (const bf16_t*)(ws + WS_KS), (const bf16_t*)(ws + WS_KW), VT, (const float*)(ws + WS_BLUT), O, wave);
            }
        } else if (ph == 10) {
            LANE_TID
            for (int row = gw; row < MTOK; row += 4 * ngw) { const int rows[4] = {row, row + ngw, row + 2 * ngw, row + 3 * ngw}; final_rows<4>(XB, SSP, out, a.in[19], rows, lane); }
        }
        if (ph0 + 1 < a.ph_hi) {
            XcdBarrier xbar; xbar.bar = (unsigned*)(ws + WS_BAR); xbar.x = xb_xcc_id(); xbar.st = bar_st;
            xcd_barrier(xbar);
        }
    }
}

extern "C" void kernel_launch(void* const* d_in, const int* in_sizes, int n_in, void* d_out, int out_size, void* d_ws, size_t ws_size, hipStream_t stream) {
    static int grid_blocks = 0;
    if (grid_blocks == 0) {
        if (n_in != 20 || ws_size < WS_END) { fprintf(stderr, "kernel_launch: unexpected n_in %d / ws_size %zu\n", n_in, ws_size); grid_blocks = -1; return; }
        int dev = 0, cus = 0, per_cu = 0;
        hipGetDevice(&dev);
        hipDeviceGetAttribute(&cus, hipDeviceAttributeMultiprocessorCount, dev);
        hipFuncSetAttribute((const void*)mega, hipFuncAttributeMaxDynamicSharedMemorySize, LDS_BYTES);
        hipOccupancyMaxActiveBlocksPerMultiprocessor(&per_cu, (const void*)mega, 512, LDS_BYTES);
        if (per_cu < 1) { fprintf(stderr, "kernel_launch: occupancy query says %d blocks/CU\n", per_cu); per_cu = 1; }
        if (per_cu > 1) per_cu = 1;
        grid_blocks = cus * per_cu;
        if (grid_blocks != 256) { fprintf(stderr, "kernel_launch: this build expects 256 workgroups (256 CUs x 1), got %d\n", grid_blocks); grid_blocks = -1; return; }
        fprintf(stderr, "kernel_launch: grid %d blocks (%d CUs)\n", grid_blocks, cus);
    }
    if (grid_blocks < 0) return;
    MegaArgs a{};
    for (int i = 0; i < 20; ++i) a.in[i] = (const float*)d_in[i];
    a.out = (float*)d_out; a.ws = (unsigned char*)d_ws; a.ph_lo = 0; a.ph_hi = NPHASE;
    void* args[] = {&a};
    hipMemsetAsync(d_ws, 0, XCD_BAR_WORDS * sizeof(unsigned), stream);
    hipError_t e = hipLaunchCooperativeKernel((const void*)mega, dim3(grid_blocks), dim3(512), args, LDS_BYTES, stream);
    if (e != hipSuccess) fprintf(stderr, "cooperative launch failed: %s (grid %d)\n", hipGetErrorString(e), grid_blocks);
}
```

```cpp
#include <hip/hip_runtime.h>
#include <hip/hip_cooperative_groups.h>
namespace cg = cooperative_groups;
#include <cstdint>
#include <cstdio>

#ifndef STAGGER
#define STAGGER 0
#endif
#ifndef PROBE_GEMM
#define PROBE_GEMM 0
#endif
#ifndef PROBE_ATT
#define PROBE_ATT 0
#endif
typedef unsigned short bf16_t;
typedef short bf16x8 __attribute__((ext_vector_type(8)));
typedef float f32x4 __attribute__((ext_vector_type(4)));
typedef float f32x16 __attribute__((ext_vector_type(16)));
typedef unsigned u32x4 __attribute__((ext_vector_type(4)));

constexpr int MTOK = 32768, DM = 1024, DFF = 2816, SEQ = 4096, NBATCH = 8, DINP = 2840;
constexpr int XLD = 1088;
constexpr float RMS_EPS = 1e-6f;
constexpr float LOG2E = 1.4426950408889634f;
constexpr float C2 = 0.125f * LOG2E;

constexpr size_t MiB = 1u << 20;
constexpr size_t WS_BAR = 0, WS_RSTD = 1 * MiB, WS_KMEAN = 2 * MiB, WS_KCMP = 3 * MiB, WS_VCMPT = 4 * MiB, WS_BIAS1 = 5 * MiB, WS_BLUT = 5 * MiB + 65536, WS_SSPART = 6 * MiB;
constexpr size_t WS_WGU1 = 8 * MiB, WS_WD1 = 19 * MiB, WS_WGU2 = 25 * MiB, WS_WD2 = 36 * MiB, WS_WINA = 42 * MiB, WS_WINB = 46 * MiB, WS_WOUT = 48 * MiB,
                 WS_W1K = 50 * MiB, WS_W1V = 51 * MiB, WS_PK = 52 * MiB, WS_PV = 60 * MiB;
constexpr size_t WS_P = 368 * MiB;
constexpr size_t WS_XB = 72 * MiB, WS_H = 140 * MiB, WS_VT = 316 * MiB, WS_O = 368 * MiB, WS_END = 436 * MiB;
constexpr size_t VT_VA = 0, VT_VS = (size_t)16 * 1024 * 1024, VT_VW = (size_t)20 * 1024 * 1024, VT_G = (size_t)24 * 1024 * 1024;
constexpr size_t WS_QA = WS_H, WS_KA = WS_H + 32 * MiB, WS_QB = WS_H + 64 * MiB, WS_KC = WS_H + 96 * MiB, WS_VC = WS_H + 104 * MiB, WS_KS = WS_H + 112 * MiB, WS_KW = WS_H + 120 * MiB;

__device__ __forceinline__ unsigned f2bf(float f) { unsigned u = __builtin_bit_cast(unsigned, f); return (u + 0x7fffu + ((u >> 16) & 1u)) >> 16; }
__device__ __forceinline__ float bf2f(unsigned short b) { return __builtin_bit_cast(float, (unsigned)b << 16); }
__device__ __forceinline__ unsigned pk2(float lo, float hi) { return f2bf(lo) | (f2bf(hi) << 16); }
template <int K> __device__ __forceinline__ float swz_xor(float v) {
    return __builtin_bit_cast(float, __builtin_amdgcn_ds_swizzle(__builtin_bit_cast(int, v), (K << 10) | 0x1f));
}
__device__ __forceinline__ void swap_x32(float v, float& o0, float& o1) {
    const unsigned a = __builtin_bit_cast(unsigned, v);
    const auto rr = __builtin_amdgcn_permlane32_swap(a, a, false, false);
    unsigned r0 = rr[0], r1 = rr[1];
    asm volatile("" : "+v"(r0), "+v"(r1));
    o0 = __builtin_bit_cast(float, r0); o1 = __builtin_bit_cast(float, r1);
}
__device__ __forceinline__ float sum_x32(float v) { float a, b; swap_x32(v, a, b); return a + b; }
__device__ __forceinline__ float max_x32(float v) { float a, b; swap_x32(v, a, b); return fmaxf(a, b); }
__device__ __forceinline__ float wave_sum(float v) {
    v += swz_xor<1>(v); v += swz_xor<2>(v); v += swz_xor<4>(v); v += swz_xor<8>(v); v += swz_xor<16>(v);
    return sum_x32(v);
}
__device__ __forceinline__ float wave_max(float v) {
    v = fmaxf(v, swz_xor<1>(v)); v = fmaxf(v, swz_xor<2>(v)); v = fmaxf(v, swz_xor<4>(v)); v = fmaxf(v, swz_xor<8>(v)); v = fmaxf(v, swz_xor<16>(v));
    return max_x32(v);
}
__device__ __forceinline__ float lane_read(float v, int src_lane) {
    return __builtin_bit_cast(float, __builtin_amdgcn_ds_bpermute(src_lane << 2, __builtin_bit_cast(int, v)));
}
__device__ __forceinline__ int rel_bucket(int d) {
    if (d < 16) return d;
    return 16 + (d >= 19) + (d >= 21) + (d >= 24) + (d >= 27) + (d >= 31) + (d >= 35) + (d >= 40) + (d >= 46) + (d >= 52) + (d >= 59) + (d >= 67) + (d >= 77) + (d >= 87) + (d >= 99) + (d >= 113);
}
__device__ __forceinline__ int crow(int r, int hi) { return (r & 3) + 8 * (r >> 2) + 4 * hi; }

#define GAS __attribute__((address_space(1)))
#define LAS3 __attribute__((address_space(3)))
struct TrDesc { const float* W; const float* gain; bf16_t* dst; int N, K, col0, nvalid, k0; };
__device__ __forceinline__ void tr_load(const TrDesc& d, f32x4 (&v)[8], int lane) {
#pragma unroll
    for (int i = 0; i < 8; ++i) {
        const int kk = 8 * i + (lane >> 3), c4 = lane & 7;
        v[i] = (f32x4){0.f, 0.f, 0.f, 0.f};
        if (4 * c4 < d.nvalid) { v[i] = *(const GAS f32x4*)(d.W + (size_t)(d.k0 + kk) * d.N + d.col0 + 4 * c4); if (d.gain) v[i] = v[i] * ((const GAS float*)d.gain)[d.k0 + kk]; }
    }
}
__device__ __forceinline__ void tr_finish(const TrDesc& d, const f32x4 (&v)[8], LAS3 float* scr, int lane) {
#pragma unroll
    for (int i = 0; i < 8; ++i) {
        const int kk = 8 * i + (lane >> 3), c4 = lane & 7;
        LAS3 float* s = scr + kk * 33 + 4 * c4;
        s[0] = v[i][0]; s[1] = v[i][1]; s[2] = v[i][2]; s[3] = v[i][3];
    }
    asm volatile("s_waitcnt lgkmcnt(0)" ::: "memory");
    const int c8 = lane & 7;
#pragma unroll
    for (int j = 0; j < 4; ++j) {
        const int n = (lane >> 3) + 8 * j; const LAS3 float* s = scr + (8 * c8) * 33 + n;
        u32x4 o; o.x = pk2(s[0 * 33], s[1 * 33]); o.y = pk2(s[2 * 33], s[3 * 33]); o.z = pk2(s[4 * 33], s[5 * 33]); o.w = pk2(s[6 * 33], s[7 * 33]);
        *(GAS u32x4*)(d.dst + (size_t)n * d.K + d.k0 + 8 * c8) = o;
    }
    asm volatile("s_waitcnt lgkmcnt(0)" ::: "memory");
}
struct MegaArgs { const float* in[20]; float* out; unsigned char* ws; int ph_lo, ph_hi; };
typedef MegaArgs PrepArgs;
constexpr int I_GU = 176 * 16, I_DN = 32 * 44, I_INA = 64 * 16, I_INB = 32 * 16, I_OUT = 32 * 16, I_W1 = 16 * 16;
constexpr int I_TOTAL = 2 * I_GU + 2 * I_DN + I_INA + I_INB + I_OUT + 2 * I_W1;
__device__ __forceinline__ TrDesc prep_desc(const PrepArgs& a, int it) {
    unsigned char* ws = a.ws;
    int r = it;
    for (int f = 0; f < 2; ++f) {
        if (r < I_GU) {
            const int rb = r / 16, kb = r % 16, dr0 = 32 * rb, pn = dr0 >> 8, within = dr0 & 255;
            return TrDesc{a.in[(f ? 15 : 2) + (within >= 128 ? 1 : 0)], a.in[f ? 14 : 1], (bf16_t*)(ws + (f ? WS_WGU2 : WS_WGU1)) + (size_t)dr0 * DM, DFF, DM, 128 * pn + (within & 127), 32, 64 * kb};
        }
        r -= I_GU;
    }
    for (int f = 0; f < 2; ++f) {
        if (r < I_DN) {
            const int rb = r / 44, kb = r % 44;
            return TrDesc{a.in[f ? 17 : 4], nullptr, (bf16_t*)(ws + (f ? WS_WD2 : WS_WD1)) + (size_t)(32 * rb) * DFF, DM, DFF, 32 * rb, 32, 64 * kb};
        }
        r -= I_DN;
    }
    if (r < I_INA) {
        const int rb = r / 16, kb = r % 16, dr0 = 32 * rb;
        int col0;
        if (dr0 < 1024) col0 = dr0; else if (dr0 < 1536) col0 = 1536 + (dr0 - 1024); else if (dr0 < 1920) col0 = dr0 + 512; else col0 = 2560 + (dr0 - 1920);
        return TrDesc{a.in[6], a.in[5], (bf16_t*)(ws + WS_WINA) + (size_t)dr0 * DM, DINP, DM, col0, 32, 64 * kb};
    }
    r -= I_INA;
    if (r < I_INB) {
        const int rb = r / 16, kb = r % 16, dr0 = 32 * rb;
        int col0, nv = 32;
        if (dr0 < 512) col0 = 1024 + dr0; else if (dr0 < 640) col0 = 2432 + (dr0 - 512); else if (dr0 < 768) col0 = 2688 + (dr0 - 640); else if (dr0 == 768) { col0 = 2816; nv = 24; } else { col0 = 0; nv = 0; }
        return TrDesc{a.in[6], a.in[5], (bf16_t*)(ws + WS_WINB) + (size_t)dr0 * DM, DINP, DM, col0, nv, 64 * kb};
    }
    r -= I_INB;
    if (r < I_OUT) {
        const int rb = r / 16, kb = r % 16;
        return TrDesc{a.in[13], nullptr, (bf16_t*)(ws + WS_WOUT) + (size_t)(32 * rb) * DM, DM, DM, 32 * rb, 32, 64 * kb};
    }
    r -= I_OUT;
    const int f = r >= I_W1 ? 1 : 0; r -= f * I_W1;
    const int rb = r / 16, kb = r % 16, dr0 = 32 * rb, half = dr0 >> 8, j0 = dr0 & 255;
    return TrDesc{a.in[f ? 11 : 8] + (size_t)half * 1024 * 256, nullptr, (bf16_t*)(ws + (f ? WS_W1V : WS_W1K)) + (size_t)dr0 * 1024, 256, 1024, j0, 32, 64 * kb};
}
__device__ __forceinline__ void ph_prep(const PrepArgs& a, LAS3 float* scr_wave, int gw, int ngw, int lane) {
    if (gw >= ngw - 128) {
        const int wv4 = gw - (ngw - 128), q4 = wv4 >> 5, wv = wv4 & 31, kv = wv >> 4, j0 = (wv & 15) * 16;
        const float* pos = a.in[kv ? 10 : 7]; const float* w1 = a.in[kv ? 11 : 8];
        f32x4 s[4];
#pragma unroll
        for (int e = 0; e < 4; ++e) s[e] = (f32x4){0.f, 0.f, 0.f, 0.f};
#pragma unroll
        for (int it8 = 0; it8 < 8; ++it8) {
            const int it = q4 * 8 + it8;
            const int kk = it * 64 + lane; const float p = ((const GAS float*)pos)[kk];
#pragma unroll
            for (int e = 0; e < 4; ++e) s[e] += *(const GAS f32x4*)(w1 + (size_t)kk * 256 + j0 + 4 * e) * p;
        }
#pragma unroll
        for (int e = 0; e < 4; ++e)
#pragma unroll
            for (int c = 0; c < 4; ++c) { const float v = wave_sum(s[e][c]); if (lane == 0) ((float*)(a.ws + WS_BIAS1))[q4 * 512 + kv * 256 + j0 + 4 * e + c] = v; }
    }
    if (gw < 112) {
        const int idx = gw * 64 + lane;
        if (idx < 16 * 432) {
            const int hd = idx / 432, j = idx - hd * 432;
            float v;
            if (j >= 304) v = a.in[18][rel_bucket(j - 304) * 16 + hd] * LOG2E;
            else if (j > 207) v = -INFINITY;
            else { const int d = 207 - j; v = a.in[18][rel_bucket(d > 127 ? 127 : d) * 16 + hd] * LOG2E; }
            ((float*)(a.ws + WS_BLUT))[idx] = v;
        }
    }
    if (gw < I_TOTAL) {
        TrDesc d = prep_desc(a, gw); f32x4 v[8];
        tr_load(d, v, lane);
        for (int it = gw; it < I_TOTAL; it += ngw) {
            TrDesc dn = d; f32x4 vn[8];
            const bool more = it + ngw < I_TOTAL;
            if (more) { dn = prep_desc(a, it + ngw); tr_load(dn, vn, lane); }
            tr_finish(d, v, scr_wave, lane);
            if (more) {
                d = dn;
#pragma unroll
                for (int i = 0; i < 8; ++i) v[i] = vn[i];
            }
        }
    }
}

__device__ __forceinline__ void rownorm_row(const float* x, bf16_t* xb, float* sspart, int row, int lane) {
    const f32x4* xr = (const f32x4*)(x + (size_t)row * DM) + lane;
    f32x4 v[4]; float s = 0.f;
#pragma unroll
    for (int j = 0; j < 4; ++j) { v[j] = xr[64 * j]; s += (v[j].x * v[j].x + v[j].y * v[j].y) + (v[j].z * v[j].z + v[j].w * v[j].w); }
    s = wave_sum(s);
    if (lane < 16) sspart[(size_t)row * 16 + lane] = lane == 0 ? s : 0.f;
    unsigned long long* o8 = (unsigned long long*)(xb + (size_t)row * XLD) + lane;
#pragma unroll
    for (int j = 0; j < 4; ++j) o8[64 * j] = (unsigned long long)pk2(v[j].x, v[j].y) | ((unsigned long long)pk2(v[j].z, v[j].w) << 32);
}
__device__ __forceinline__ void rownorm_row2(const float* x, bf16_t* xb, float* sspart, int row0, int row1, int lane) {
    const bool has1 = row1 < MTOK;
    const GAS f32x4* xr0 = (const GAS f32x4*)(x + (size_t)row0 * DM) + lane;
    const GAS f32x4* xr1 = (const GAS f32x4*)(x + (size_t)(has1 ? row1 : row0) * DM) + lane;
    f32x4 v0[4], v1[4]; float s0 = 0.f, s1 = 0.f;
#pragma unroll
    for (int j = 0; j < 4; ++j) { v0[j] = xr0[64 * j]; v1[j] = xr1[64 * j]; }
#pragma unroll
    for (int j = 0; j < 4; ++j) {
        s0 += (v0[j].x * v0[j].x + v0[j].y * v0[j].y) + (v0[j].z * v0[j].z + v0[j].w * v0[j].w);
        s1 += (v1[j].x * v1[j].x + v1[j].y * v1[j].y) + (v1[j].z * v1[j].z + v1[j].w * v1[j].w);
    }
    s0 = wave_sum(s0); s1 = wave_sum(s1);
    if (lane < 16) { ((GAS float*)sspart)[(size_t)row0 * 16 + lane] = lane == 0 ? s0 : 0.f; if (has1) ((GAS float*)sspart)[(size_t)row1 * 16 + lane] = lane == 0 ? s1 : 0.f; }
    GAS unsigned long long* o0 = (GAS unsigned long long*)(xb + (size_t)row0 * XLD) + lane;
    GAS unsigned long long* o1 = (GAS unsigned long long*)(xb + (size_t)row1 * XLD) + lane;
#pragma unroll
    for (int j = 0; j < 4; ++j) {
        o0[64 * j] = (unsigned long long)pk2(v0[j].x, v0[j].y) | ((unsigned long long)pk2(v0[j].z, v0[j].w) << 32);
        if (has1) o1[64 * j] = (unsigned long long)pk2(v1[j].x, v1[j].y) | ((unsigned long long)pk2(v1[j].z, v1[j].w) << 32);
    }
}
__device__ __forceinline__ float final_rstd(const float* sspart, int row, int lane) {
    float s = lane < 16 ? sspart[(size_t)row * 16 + lane] : 0.f;
    s += swz_xor<1>(s); s += swz_xor<2>(s); s += swz_xor<4>(s); s += swz_xor<8>(s);
    s = __builtin_bit_cast(float, __builtin_amdgcn_readfirstlane(__builtin_bit_cast(int, s)));
    return __builtin_amdgcn_rsqf(s * (1.0f / DM) + RMS_EPS);
}
template <int NR>
__device__ __forceinline__ void final_rows(const bf16_t* xb, const float* sspart, float* y, const float* g, const int (&rows)[NR], int lane) {
    u32x4 w[NR][2]; float ss[NR]; f32x4 gv[2][2];
#pragma unroll
    for (int i = 0; i < NR; ++i) {
        const int row = rows[i] < MTOK ? rows[i] : 0;
        ss[i] = lane < 16 ? ((const GAS float*)sspart)[(size_t)row * 16 + lane] : 0.f;
        const GAS u32x4* xr = (const GAS u32x4*)(xb + (size_t)row * XLD) + lane;
        w[i][0] = xr[0]; w[i][1] = xr[64];
    }
#pragma unroll
    for (int j = 0; j < 2; ++j) { gv[j][0] = ((const GAS f32x4*)g)[(64 * j + lane) * 2]; gv[j][1] = ((const GAS f32x4*)g)[(64 * j + lane) * 2 + 1]; }
#pragma unroll
    for (int i = 0; i < NR; ++i) {
        if (rows[i] >= MTOK) continue;
        float s = ss[i];
        s += swz_xor<1>(s); s += swz_xor<2>(s); s += swz_xor<4>(s); s += swz_xor<8>(s);
        s = __builtin_bit_cast(float, __builtin_amdgcn_readfirstlane(__builtin_bit_cast(int, s)));
        const float r = __builtin_amdgcn_rsqf(s * (1.0f / DM) + RMS_EPS);
        GAS f32x4* yr = (GAS f32x4*)(y + (size_t)rows[i] * DM);
#pragma unroll
        for (int j = 0; j < 2; ++j) {
            const u32x4 ww = w[i][j];
            const int c4 = (64 * j + lane) * 2;
            const f32x4 v0 = {__builtin_bit_cast(float, ww.x << 16), __builtin_bit_cast(float, ww.x & 0xffff0000u), __builtin_bit_cast(float, ww.y << 16), __builtin_bit_cast(float, ww.y & 0xffff0000u)};
            const f32x4 v1 = {__builtin_bit_cast(float, ww.z << 16), __builtin_bit_cast(float, ww.z & 0xffff0000u), __builtin_bit_cast(float, ww.w << 16), __builtin_bit_cast(float, ww.w & 0xffff0000u)};
            yr[c4] = v0 * r * gv[j][0]; yr[c4 + 1] = v1 * r * gv[j][1];
        }
    }
}

namespace pg8 {
#define PG8_LAS __attribute__((address_space(3)))
#define PG8_GAS __attribute__((address_space(1)))
typedef unsigned short bf16_t;
typedef short bf16x8 __attribute__((ext_vector_type(8)));
typedef float f32x4 __attribute__((ext_vector_type(4)));
typedef unsigned u32x4 __attribute__((ext_vector_type(4)));
constexpr int BM = 256, BK = 64, HALF = 128, HTB = HALF * BK * 2  , STAGE_BYTES = 8 * HTB, NXCD = 8, WGM = 8;

__host__ __device__ __forceinline__ int lds_byte(int r, int c) { const int st = (r >> 4) * 2 + (c >> 5), rr = r & 15, cc = c & 31, ob = rr * 64 + cc * 2; return st * 1024 + (ob ^ (((ob >> 9) & 1) << 5)); }
__host__ __device__ __forceinline__ void stage_rc(int b, int& R, int& C) { const int st = b / 1024, sb = b % 1024, swz = sb ^ (((sb >> 9) & 1) << 5); R = (st >> 1) * 16 + swz / 64; C = (st & 1) * 32 + (swz % 64) / 2; }
__host__ __device__ __forceinline__ int perm32(int rho) { const int n = rho >> 4, i = rho & 15; return 8 * (i >> 2) + 4 * n + (i & 3); }

struct Unit { int pm, pn; };
struct Gemm { const bf16_t* A; const bf16_t* Bt; int M, N, K; int lda, ldb; };

struct StaticOrder {
    int nM, nN, nwg, G, c; bool rev = false;
    __host__ __device__ void init(int M, int N, int G_, int c_) { nM = M / BM; nN = N / BM; nwg = nM * nN; G = G_; c = c_; }
    __device__ bool next(int i, Unit& u) const {
        const long L = (long)i * G + c; if (L >= nwg) return false;
        int wgid = (int)L; { const int q = nwg / NXCD, r = nwg % NXCD, xcd = wgid % NXCD, off = wgid / NXCD; wgid = (xcd < r ? xcd * (q + 1) : r * (q + 1) + (xcd - r) * q) + off; }
        const int nig = WGM * nN, gid = wgid / nig, fm = gid * WGM, gsz = (nM - fm) < WGM ? (nM - fm) : WGM;
        const int pm_ = fm + ((wgid % nig) % gsz);
        u.pm = __builtin_amdgcn_readfirstlane(rev ? nM - 1 - pm_ : pm_); u.pn = __builtin_amdgcn_readfirstlane((wgid % nig) / gsz); return true;
    }
    __device__ __forceinline__ void a_ready(const Unit&) const {}
    __device__ __forceinline__ void done(const Unit&) const {}
};


#ifndef USE_NT
#define USE_NT 0
#endif
#if USE_NT
#define NT_LD(p) ld_nt(p)
#define NT_ST(p, v) st_nt(p, v)
#else
#define NT_LD(p) (*(const PG8_GAS u32x4*)(p))
#define NT_ST(p, v) (*(PG8_GAS u32x4*)(p) = (v))
#endif
__device__ __forceinline__ u32x4 ld_nt(const u32x4* p) { return __builtin_nontemporal_load(p); }
__device__ __forceinline__ void st_nt(u32x4* p, u32x4 v) { __builtin_nontemporal_store(v, p); }
__device__ __forceinline__ unsigned cvt_pk_bf16(float lo, float hi) { unsigned r; asm volatile("v_cvt_pk_bf16_f32 %0, %1, %2" : "=v"(r) : "v"(lo), "v"(hi)); return r; }
__device__ __forceinline__ u32x4 pack8(const f32x4 a, const f32x4 b) { u32x4 w; w.x = cvt_pk_bf16(a[0], a[1]); w.y = cvt_pk_bf16(a[2], a[3]); w.z = cvt_pk_bf16(b[0], b[1]); w.w = cvt_pk_bf16(b[2], b[3]); return w; }
__device__ __forceinline__ float row_rstd(const float* sspart, int row, int fq) {
    const f32x4 v = *(const PG8_GAS f32x4*)(sspart + (size_t)row * 16 + 4 * fq);
    float s = (v[0] + v[1]) + (v[2] + v[3]);
    s += swz_xor<16>(s); s = sum_x32(s);
    return __builtin_amdgcn_rsqf(s * (1.0f / 1024.0f) + 1e-6f);
}
__device__ __forceinline__ void row_rstd8(float (&rr)[2][4], const float* sspart, int row0, int fq) {
    f32x4 sp[2][4];
#pragma unroll
    for (int ai = 0; ai < 2; ++ai)
#pragma unroll
        for (int m = 0; m < 4; ++m) sp[ai][m] = *(const PG8_GAS f32x4*)(sspart + (size_t)(row0 + ai * HALF + m * 16) * 16 + 4 * fq);
#pragma unroll
    for (int ai = 0; ai < 2; ++ai)
#pragma unroll
        for (int m = 0; m < 4; ++m) {
            const f32x4 v = sp[ai][m];
            float s = (v[0] + v[1]) + (v[2] + v[3]);
            s += swz_xor<16>(s); s = sum_x32(s);
            rr[ai][m] = __builtin_amdgcn_rsqf(s * (1.0f / 1024.0f) + 1e-6f);
        }
}
__device__ __forceinline__ float silu_mul(float g, float u) { return g * __builtin_amdgcn_rcpf(1.0f + __builtin_amdgcn_exp2f(-1.4426950408889634f * g)) * u; }
__device__ __forceinline__ float sigmoid_f(float g) { return __builtin_amdgcn_rcpf(1.0f + __builtin_amdgcn_exp2f(-1.4426950408889634f * g)); }

struct EpiSwigluF {
    static constexpr bool PERM = true, AFTER_DRAIN = false;
    bf16_t* H; const float* sspart; PG8_LAS float* cache;
    __device__ __forceinline__ void operator()(const f32x4 (&acc)[2][2][4][2], const Unit& u, int wr, int wc, int fr, int fq) const {
        const int row0 = u.pm * BM + wr * 64 + fr, col0 = u.pn * 128 + wc * 32 + 8 * fq;
        float rr[2][4];
        PG8_LAS float* slot = cache + (((wr * 4 + wc) * 64 + fq * 16 + fr) * 9);
        if (__builtin_bit_cast(int, slot[0]) == u.pm) {
#pragma unroll
            for (int k = 0; k < 8; ++k) rr[k >> 2][k & 3] = slot[1 + k];
        } else {
            row_rstd8(rr, sspart, row0, fq);
            slot[0] = __builtin_bit_cast(float, u.pm);
#pragma unroll
            for (int k = 0; k < 8; ++k) slot[1 + k] = rr[k >> 2][k & 3];
        }
#pragma unroll
        for (int ai = 0; ai < 2; ++ai)
#pragma unroll
            for (int m = 0; m < 4; ++m) {
                const int row = row0 + ai * HALF + m * 16;
                const float r = rr[ai][m];
                const float rl = -1.4426950408889634f * r, r2 = r * r;
                f32x4 h[2];
#pragma unroll
                for (int n = 0; n < 2; ++n) {
                    const f32x4 g = acc[ai][0][m][n], uu = acc[ai][1][m][n];
                    f32x4 e = g * rl;
#pragma unroll
                    for (int k = 0; k < 4; ++k) e[k] = __builtin_amdgcn_rcpf(1.0f + __builtin_amdgcn_exp2f(e[k]));
                    h[n] = (g * uu) * (e * r2);
                }
                NT_ST((u32x4*)(H + (size_t)row * 2816 + col0), pack8(h[0], h[1]));
            }
    }
};
struct EpiResidF {
    static constexpr bool PERM = true, AFTER_DRAIN = false;
    const float* res32; bf16_t* xb; float* sspart; float scale; int pad;
    __device__ __forceinline__ void operator()(const f32x4 (&acc)[2][2][4][2], const Unit& u, int wr, int wc, int fr, int fq) const {
        const int row0 = u.pm * BM + wr * 64 + fr, col0 = u.pn * BM + wc * 32 + 8 * fq;
#pragma unroll
        for (int ai = 0; ai < 2; ++ai) {
            f32x4 rs[4][2][2];
            if (pad == 1) {
#pragma unroll
                for (int m = 0; m < 4; ++m)
#pragma unroll
                    for (int bj = 0; bj < 2; ++bj) { rs[m][bj][0] = (f32x4){0.f, 0.f, 0.f, 0.f}; rs[m][bj][1] = (f32x4){0.f, 0.f, 0.f, 0.f}; }
            } else if (res32) {
#pragma unroll
                for (int m = 0; m < 4; ++m)
#pragma unroll
                    for (int bj = 0; bj < 2; ++bj) {
                        const size_t off = (size_t)(row0 + ai * HALF + m * 16) * 1024 + col0 + bj * HALF;
                        rs[m][bj][0] = *(const PG8_GAS f32x4*)(res32 + off); rs[m][bj][1] = *(const PG8_GAS f32x4*)(res32 + off + 4);
                    }
            } else {
                u32x4 rb[4][2];
#pragma unroll
                for (int m = 0; m < 4; ++m)
#pragma unroll
                    for (int bj = 0; bj < 2; ++bj) rb[m][bj] = NT_LD((const u32x4*)(xb + (size_t)(row0 + ai * HALF + m * 16) * XLD + col0 + bj * HALF));
#pragma unroll
                for (int m = 0; m < 4; ++m)
#pragma unroll
                    for (int bj = 0; bj < 2; ++bj) {
                        const u32x4 w = rb[m][bj];
                        rs[m][bj][0] = (f32x4){__builtin_bit_cast(float, w.x << 16), __builtin_bit_cast(float, w.x & 0xffff0000u), __builtin_bit_cast(float, w.y << 16), __builtin_bit_cast(float, w.y & 0xffff0000u)};
                        rs[m][bj][1] = (f32x4){__builtin_bit_cast(float, w.z << 16), __builtin_bit_cast(float, w.z & 0xffff0000u), __builtin_bit_cast(float, w.w << 16), __builtin_bit_cast(float, w.w & 0xffff0000u)};
                    }
            }
#pragma unroll
            for (int m = 0; m < 4; ++m) {
                const int row = row0 + ai * HALF + m * 16;
                const size_t off = (size_t)row * XLD + col0;
                float ss = 0.f;
#pragma unroll
                for (int bj = 0; bj < 2; ++bj) {
                    const f32x4 v0 = rs[m][bj][0] + acc[ai][bj][m][0] * scale, v1 = rs[m][bj][1] + acc[ai][bj][m][1] * scale;
                    ss += (v0[0] * v0[0] + v0[1] * v0[1]) + (v0[2] * v0[2] + v0[3] * v0[3]) + (v1[0] * v1[0] + v1[1] * v1[1]) + (v1[2] * v1[2] + v1[3] * v1[3]);
                    if (pad != 2) NT_ST((u32x4*)(xb + off + bj * HALF), pack8(v0, v1));
                }
                ss += swz_xor<16>(ss); ss = sum_x32(ss);
                if (fq == 0) ((PG8_GAS float*)sspart)[(size_t)row * 16 + u.pn * 4 + wc] = ss;
            }
            asm volatile("" ::: "memory");
        }
    }
};
struct EpiProjAF {
    static constexpr bool PERM = true, AFTER_DRAIN = false;
    unsigned char* ws; const float* sspart;
    __device__ __forceinline__ void operator()(const f32x4 (&acc)[2][2][4][2], const Unit& u, int wr, int wc, int fr, int fq) const {
        const int row0 = u.pm * BM + wr * 64 + fr;
        float rr[2][4];
        row_rstd8(rr, sspart, row0, fq);
#pragma unroll
        for (int bj = 0; bj < 2; ++bj) {
            const int col = u.pn * BM + bj * HALF + wc * 32;
            size_t base; int nh, hh; float sc = 1.0f;
            if (col < 512) { base = WS_QA; nh = 8; hh = col >> 6; sc = C2; }
            else if (col < 1024) { base = WS_KA; nh = 8; hh = (col - 512) >> 6; }
            else if (col < 1536) { base = WS_QB; nh = 8; hh = (col - 1024) >> 6; sc = C2; }
            else if (col < 1664) { base = WS_KC; nh = 2; hh = (col - 1536) >> 6; }
            else if (col < 1792) { base = WS_VC; nh = 2; hh = (col - 1664) >> 6; }
            else if (col < 1920) { base = WS_KS; nh = 2; hh = (col - 1792) >> 6; }
            else { base = WS_KW; nh = 2; hh = (col - 1920) >> 6; }
            bf16_t* T = (bf16_t*)(ws + base);
            const int d0 = (col & 63) + 8 * fq;
#pragma unroll
            for (int ai = 0; ai < 2; ++ai)
#pragma unroll
                for (int m = 0; m < 4; ++m) {
                    const int row = row0 + ai * HALF + m * 16, b = row >> 12, s = row & 4095;
                    const float r = rr[ai][m] * sc;
                    *(PG8_GAS u32x4*)(T + ((size_t)(b * nh + hh) * 4096 + s) * 64 + d0) = pack8(acc[ai][bj][m][0] * r, acc[ai][bj][m][1] * r);
                }
        }
    }
};
struct EpiProjBF {
    static constexpr bool PERM = true, AFTER_DRAIN = false;
    bf16_t* VT; const float* sspart;
    __device__ __forceinline__ void operator()(const f32x4 (&acc)[2][2][4][2], const Unit& u, int wr, int wc, int fr, int fq) const {
        const int lane = fq * 16 + fr;
        const int f0 = u.pm * BM + wr * 64 + fr;
#pragma unroll
        for (int bj = 0; bj < 2; ++bj) {
            const int tokw = u.pn * BM + bj * HALF + wc * 32;
            float rt;
            {
                const float* p = sspart + (size_t)(tokw + (lane & 31)) * 16 + 8 * (lane >> 5);
                const f32x4 a = *(const PG8_GAS f32x4*)p, b = *(const PG8_GAS f32x4*)(p + 4);
                float s = ((a[0] + a[1]) + (a[2] + a[3])) + ((b[0] + b[1]) + (b[2] + b[3]));
                s = sum_x32(s);
                rt = __builtin_amdgcn_rsqf(s * (1.0f / 1024.0f) + 1e-6f);
            }
            f32x4 rs0, rs1;
#pragma unroll
            for (int e = 0; e < 4; ++e) { rs0[e] = lane_read(rt, 8 * fq + e); rs1[e] = lane_read(rt, 8 * fq + 4 + e); }
            const int tok0 = tokw + 8 * fq;
#pragma unroll
            for (int ai = 0; ai < 2; ++ai)
#pragma unroll
                for (int m = 0; m < 4; ++m) {
                    const int fu = u.pm * BM + wr * 64 + ai * HALF + m * 16;
                    const int f = fu + fr;
                    f32x4 v0 = acc[ai][bj][m][0] * rs0, v1 = acc[ai][bj][m][1] * rs1;
                    if (fu >= 768) {
                        if (fu >= 800) continue;
#pragma unroll
                        for (int e = 0; e < 4; ++e) { v0[e] = sigmoid_f(v0[e]); v1[e] = sigmoid_f(v1[e]); }
                        if (f < 792) *(PG8_GAS u32x4*)(VT + VT_G + (size_t)(f - 768) * 32768 + tok0) = pack8(v0, v1);
                    } else {
                        const int bb = tok0 >> 12, tile = (tok0 >> 6) & 63, k0 = tok0 & 63;
                        const size_t base = fu < 512 ? VT_VA : fu < 640 ? VT_VS : VT_VW;
                        const int hx = fu < 512 ? (fu >> 6) : fu < 640 ? ((fu - 512) >> 6) : ((fu - 640) >> 6), nhx = fu < 512 ? 8 : 2;
                        *(PG8_GAS u32x4*)(VT + base + (((size_t)(bb * nhx + hx) * 64 + tile) * 64 + (f & 63)) * 64 + k0) = pack8(v0, v1);
                    }
                }
        }
    }
};
struct EpiNullF {
    static constexpr bool PERM = true, AFTER_DRAIN = false;
    int pad0, pad1;
    __device__ __forceinline__ void operator()(const f32x4 (&acc)[2][2][4][2], const Unit&, int, int, int, int) const {
#pragma unroll
        for (int ai = 0; ai < 2; ++ai)
#pragma unroll
            for (int bj = 0; bj < 2; ++bj)
#pragma unroll
                for (int m = 0; m < 4; ++m) asm volatile("" :: "v"(acc[ai][bj][m][0]), "v"(acc[ai][bj][m][1]));
    }
};
struct EpiF32F {
    static constexpr bool PERM = true, AFTER_DRAIN = false;
    bf16_t* P; int ld; int pad;
    __device__ __forceinline__ void operator()(const f32x4 (&acc)[2][2][4][2], const Unit& u, int wr, int wc, int fr, int fq) const {
        const int row0 = u.pm * BM + wr * 64 + fr, col0 = u.pn * BM + wc * 32 + 8 * fq;
#pragma unroll
        for (int ai = 0; ai < 2; ++ai)
#pragma unroll
            for (int m = 0; m < 4; ++m) { bf16_t* rowp = P + (size_t)(row0 + ai * HALF + m * 16) * ld + col0;
#pragma unroll
                for (int bj = 0; bj < 2; ++bj) *(PG8_GAS u32x4*)(rowp + bj * HALF) = pack8(acc[ai][bj][m][0], acc[ai][bj][m][1]); }
    }
};

template <class Epi, class Sched, bool ALIGN_EPI = false, bool SP2 = false>
__device__ __forceinline__ void gemm_phase(PG8_LAS unsigned char* lds, const Gemm g, const Sched& S, const Epi& E, const int tid) {
    const int wid = __builtin_amdgcn_readfirstlane(tid >> 6), lane = tid & 63, wr = wid >> 2, wc = wid & 3, fr = lane & 15, fq = lane >> 4;
    const int KA_ = g.lda ? g.lda : g.K, KB_ = g.ldb ? g.ldb : g.K, nt = g.K / BK;
    unsigned voffA[2], voffB[2];
#pragma unroll
    for (int i = 0; i < 2; ++i) { int R, C; stage_rc(tid * 16 + i * 8192, R, C); const int Rb = Epi::PERM ? ((R & ~31) + perm32(R & 31)) : R;
        voffA[i] = (unsigned)(R * KA_ + C) * 2u; voffB[i] = (unsigned)(Rb * KB_ + C) * 2u; }
    const size_t kstep = (size_t)(BK * 2);
    const size_t hA = (size_t)HALF * KA_ * 2, hB = (size_t)HALF * KB_ * 2;
    const size_t tA = 2 * hA, tB = 2 * hB;
    const unsigned ldsw = (unsigned)wid * 1024u;
    const int aoff = lds_byte(wr * 64 + fr, fq * 8), boff = lds_byte(wc * 32 + fr, fq * 8);
#define PG8_SA(b, h) (((b) * 2 + (h)) * HTB)
#define PG8_SB(b, h) ((4 + (b) * 2 + (h)) * HTB)
#define PG8_STAGE(bufoff, gbase, voff) do { _Pragma("unroll") for (int _i = 0; _i < 2; ++_i) \
        __builtin_amdgcn_global_load_lds((const unsigned*)((const char*)(gbase) + (voff)[_i]), (PG8_LAS unsigned*)(lds + (bufoff) + ldsw + _i * 8192), 16, 0, 0); } while (0)
#define PG8_LDA(dst, b, h) do { _Pragma("unroll") for (int m = 0; m < 4; ++m) _Pragma("unroll") for (int k = 0; k < 2; ++k) dst[m][k] = *(const PG8_LAS bf16x8*)(lds + PG8_SA(b, h) + aoff + m * 2048 + k * 1024); } while (0)
#define PG8_LDB(dst, b, h) do { _Pragma("unroll") for (int n = 0; n < 2; ++n) _Pragma("unroll") for (int k = 0; k < 2; ++k) dst[n][k] = *(const PG8_LAS bf16x8*)(lds + PG8_SB(b, h) + boff + n * 2048 + k * 1024); } while (0)
#define PG8_MMA(ai, bj, At, Bt) do { __builtin_amdgcn_s_setprio(1); _Pragma("unroll") for (int m = 0; m < 4; ++m) _Pragma("unroll") for (int n = 0; n < 2; ++n) _Pragma("unroll") for (int k = 0; k < 2; ++k) \
        acc[ai][bj][m][n] = __builtin_amdgcn_mfma_f32_16x16x32_bf16(Bt[n][k], At[m][k], acc[ai][bj][m][n], 0, 0, 0); __builtin_amdgcn_s_setprio(0); } while (0)
#define PG8_WAIT_V(n) asm volatile("s_waitcnt vmcnt(" #n ")" ::: "memory")
#define PG8_WAIT_L(n) asm volatile("s_waitcnt lgkmcnt(" #n ")" ::: "memory")
#define PG8_BAR __builtin_amdgcn_s_barrier()
#define PG8_SCHED __builtin_amdgcn_sched_barrier(0)
    Unit cur, nxt; int ui = 0;
    if (!S.next(0, cur)) return;
    f32x4 acc[2][2][4][2];
#pragma unroll
    for (int a = 0; a < 2; ++a)
#pragma unroll
        for (int b = 0; b < 2; ++b)
#pragma unroll
            for (int m = 0; m < 4; ++m)
#pragma unroll
                for (int n = 0; n < 2; ++n) acc[a][b][m][n] = (f32x4){0.f, 0.f, 0.f, 0.f};
    bf16x8 At[4][2], B0[2][2], B1[2][2];
    const char* cA = (const char*)g.A + (size_t)cur.pm * tA; const char* cB = (const char*)g.Bt + (size_t)cur.pn * tB;
    S.a_ready(cur);
    if constexpr (SP2) {
        PG8_STAGE(PG8_SB(0, 0), cB, voffB); PG8_STAGE(PG8_SB(0, 1), cB + hB, voffB); PG8_STAGE(PG8_SA(0, 0), cA, voffA); PG8_STAGE(PG8_SA(0, 1), cA + hA, voffA);
        if (wr == 1) PG8_BAR;
        PG8_WAIT_V(2); PG8_BAR;
        PG8_STAGE(PG8_SB(1, 0), cB + kstep, voffB); PG8_STAGE(PG8_SA(1, 0), cA + kstep, voffA); PG8_STAGE(PG8_SB(1, 1), cB + hB + kstep, voffB);
        PG8_WAIT_V(6); PG8_BAR;
    } else {
        PG8_STAGE(PG8_SB(0, 0), cB, voffB); PG8_STAGE(PG8_SA(0, 0), cA, voffA); PG8_STAGE(PG8_SB(0, 1), cB + hB, voffB); PG8_STAGE(PG8_SA(0, 1), cA + hA, voffA);
        if (wr == 1) PG8_BAR;
        PG8_WAIT_V(4); PG8_BAR;
        PG8_STAGE(PG8_SB(1, 0), cB + kstep, voffB); PG8_STAGE(PG8_SA(1, 0), cA + kstep, voffA); PG8_STAGE(PG8_SB(1, 1), cB + hB + kstep, voffB);
        PG8_WAIT_V(6); PG8_BAR;
    }
    for (;;) {
        const bool has_next = S.next(ui + 1, nxt);
        const char* nA = has_next ? (const char*)g.A + (size_t)nxt.pm * tA : cA; const char* nB = has_next ? (const char*)g.Bt + (size_t)nxt.pn * tB : cB;
        for (int t = 0; t < nt; t += 2) {
            const bool last = (t == nt - 2);
            const char* a1 = cA + (size_t)(t + 1) * kstep;
            const char* a2 = last ? nA : cA + (size_t)(t + 2) * kstep; const char* b2 = last ? nB : cB + (size_t)(t + 2) * kstep;
            const char* a3 = a2 + kstep; const char* b3 = b2 + kstep;
            if (last && has_next) S.a_ready(nxt);
            if constexpr (SP2) {
            PG8_LDB(B0, 0, 0); PG8_LDB(B1, 0, 1); PG8_SCHED; PG8_LDA(At, 0, 0); PG8_STAGE(PG8_SA(1, 1), a1 + hA, voffA);
            PG8_WAIT_V(8); PG8_WAIT_L(0); PG8_BAR; PG8_MMA(0, 0, At, B0); PG8_MMA(0, 1, At, B1); PG8_BAR; PG8_SCHED;
            PG8_LDA(At, 0, 1); PG8_STAGE(PG8_SB(0, 0), b2, voffB); PG8_STAGE(PG8_SB(0, 1), b2 + hB, voffB); PG8_STAGE(PG8_SA(0, 0), a2, voffA);
            PG8_WAIT_V(8); PG8_WAIT_L(0); PG8_BAR; PG8_MMA(1, 0, At, B0); PG8_MMA(1, 1, At, B1); PG8_BAR; PG8_SCHED;
            PG8_LDB(B0, 1, 0); PG8_LDB(B1, 1, 1); PG8_SCHED; PG8_LDA(At, 1, 0); PG8_STAGE(PG8_SA(0, 1), a2 + hA, voffA);
            PG8_WAIT_V(8); PG8_WAIT_L(0); PG8_BAR; PG8_MMA(0, 0, At, B0); PG8_MMA(0, 1, At, B1); PG8_BAR; PG8_SCHED;
            PG8_LDA(At, 1, 1); PG8_STAGE(PG8_SB(1, 0), b3, voffB); PG8_STAGE(PG8_SB(1, 1), b3 + hB, voffB); PG8_STAGE(PG8_SA(1, 0), a3, voffA);
            PG8_WAIT_V(8); PG8_WAIT_L(0); PG8_BAR; PG8_MMA(1, 0, At, B0); PG8_MMA(1, 1, At, B1); PG8_BAR; PG8_SCHED;
            } else {
            PG8_LDB(B0, 0, 0); PG8_SCHED; PG8_LDA(At, 0, 0); PG8_STAGE(PG8_SA(1, 1), a1 + hA, voffA);
            PG8_WAIT_L(8); PG8_BAR; PG8_WAIT_L(0); PG8_MMA(0, 0, At, B0); PG8_BAR; PG8_SCHED;
            PG8_LDB(B1, 0, 1); PG8_STAGE(PG8_SB(0, 0), b2, voffB);
            PG8_BAR; PG8_WAIT_L(0); PG8_MMA(0, 1, At, B1); PG8_BAR;
            PG8_LDA(At, 0, 1); PG8_STAGE(PG8_SA(0, 0), a2, voffA);
            PG8_BAR; PG8_WAIT_L(0); PG8_MMA(1, 0, At, B0); PG8_BAR; PG8_SCHED;
            PG8_STAGE(PG8_SB(0, 1), b2 + hB, voffB);
            PG8_WAIT_V(6); PG8_BAR; PG8_MMA(1, 1, At, B1); PG8_BAR;
            PG8_LDB(B0, 1, 0); PG8_SCHED; PG8_LDA(At, 1, 0); PG8_STAGE(PG8_SA(0, 1), a2 + hA, voffA);
            PG8_WAIT_L(8); PG8_BAR; PG8_WAIT_L(0); PG8_MMA(0, 0, At, B0); PG8_BAR; PG8_SCHED;
            PG8_LDB(B1, 1, 1); PG8_STAGE(PG8_SB(1, 0), b3, voffB);
            PG8_BAR; PG8_WAIT_L(0); PG8_MMA(0, 1, At, B1); PG8_BAR;
            PG8_LDA(At, 1, 1); PG8_STAGE(PG8_SA(1, 0), a3, voffA);
            PG8_BAR; PG8_WAIT_L(0); PG8_MMA(1, 0, At, B0); PG8_BAR; PG8_SCHED;
            PG8_STAGE(PG8_SB(1, 1), b3 + hB, voffB);
            PG8_WAIT_V(6); PG8_BAR; PG8_MMA(1, 1, At, B1); PG8_BAR;
            }
        }
        if constexpr (ALIGN_EPI) { if (wr == 0) PG8_BAR; }
        if constexpr (!Epi::AFTER_DRAIN) {
            unsigned ze_; asm volatile("v_mov_b32 %0, 0" : "=v"(ze_));
            const int le_ = (int)__builtin_amdgcn_mbcnt_hi(~0u, __builtin_amdgcn_mbcnt_lo(~0u, ze_));
            E(acc, cur, wr, wc, le_ & 15, le_ >> 4); S.done(cur);
        }
        if (!has_next) break;
#pragma unroll
        for (int a = 0; a < 2; ++a)
#pragma unroll
            for (int b = 0; b < 2; ++b)
#pragma unroll
                for (int m = 0; m < 4; ++m)
#pragma unroll
                    for (int n = 0; n < 2; ++n) acc[a][b][m][n] = (f32x4){0.f, 0.f, 0.f, 0.f};
        cur = nxt; cA = nA; cB = nB; ++ui;
        if constexpr (ALIGN_EPI) { if (wr == 1) PG8_BAR; }
    }
    PG8_WAIT_V(0);
    if constexpr (!ALIGN_EPI) { if (wr == 0) PG8_BAR; }
    PG8_BAR;
    if constexpr (Epi::AFTER_DRAIN) { E.fused(acc, cur, wr, wc, fr, fq, lds, wid, lane); S.done(cur); }
#undef PG8_SA
#undef PG8_SB
#undef PG8_STAGE
#undef PG8_LDA
#undef PG8_LDB
#undef PG8_MMA
#undef PG8_WAIT_V
#undef PG8_WAIT_L
#undef PG8_BAR
#undef PG8_SCHED
}
}

__device__ __forceinline__ void kmean_item(const bf16_t* KA, float* KMEAN, int item, int lane) {
    const int bh = item >> 4, j = item & 15;
    const bf16_t* base = KA + ((size_t)bh * SEQ + 256 * j) * 64;
    const int d8 = lane & 7, rg = lane >> 3;
    float s[8];
#pragma unroll
    for (int e = 0; e < 8; ++e) s[e] = 0.f;
    for (int i0 = 0; i0 < 32; i0 += 8) {
        u32x4 vv[8];
#pragma unroll
        for (int i = 0; i < 8; ++i) vv[i] = *(const GAS u32x4*)(base + (size_t)(rg * 32 + i0 + i) * 64 + d8 * 8);
#pragma unroll
        for (int i = 0; i < 8; ++i) {
            const u32x4 v = vv[i];
            s[0] += bf2f(v.x & 0xffff); s[1] += bf2f(v.x >> 16); s[2] += bf2f(v.y & 0xffff); s[3] += bf2f(v.y >> 16);
            s[4] += bf2f(v.z & 0xffff); s[5] += bf2f(v.z >> 16); s[6] += bf2f(v.w & 0xffff); s[7] += bf2f(v.w >> 16);
        }
    }
#pragma unroll
    for (int e = 0; e < 8; ++e) { s[e] += swz_xor<8>(s[e]); s[e] += swz_xor<16>(s[e]); s[e] = sum_x32(s[e]); }
    if (rg == 0) {
#pragma unroll
        for (int e = 0; e < 8; ++e) ((GAS float*)KMEAN)[(size_t)item * 64 + d8 * 8 + e] = s[e] * (1.0f / 256.0f);
    }
}

__device__ __forceinline__ void cmp2_group(const float* P  , const float* bias1, const float* w2k, const float* w2v, bf16_t* KCMP, bf16_t* VCMPT, LAS3 float* lds_f, int grp, int tid) {
    const int kv = grp >> 7, bg = (grp >> 3) & 15, n0 = (grp & 7) * 32;
    LAS3 float* hid = lds_f; LAS3 float* w2l = lds_f + 32 * 257 + 3;
    w2l = lds_f + 8232;
    const GAS bf16_t* Pk = (const GAS bf16_t*)P + (size_t)kv * 4 * 4096 * 512; const float* w2 = kv ? w2v : w2k;
    {
        const GAS f32x4* src4 = (const GAS f32x4*)w2; LAS3 f32x4* dst4 = (LAS3 f32x4*)w2l;
#pragma unroll
        for (int i = 0; i < 8; ++i) dst4[tid + 512 * i] = src4[tid + 512 * i];
    }
    {
        const int j = tid & 255, nh = tid >> 8;
        const float bj = (((const GAS float*)bias1)[kv * 256 + j] + ((const GAS float*)bias1)[512 + kv * 256 + j]) + (((const GAS float*)bias1)[1024 + kv * 256 + j] + ((const GAS float*)bias1)[1536 + kv * 256 + j]);
#pragma unroll 1
        for (int ib = 0; ib < 16; ib += 8) {
            unsigned short pv[8][8];
#pragma unroll
            for (int i = 0; i < 8; ++i) {
                const int n = n0 + nh * 16 + ib + i, nc = n < 255 ? n : 254;
#pragma unroll
                for (int sp = 0; sp < 4; ++sp) {
                    pv[i][2 * sp] = Pk[((size_t)sp * 4096 + bg * 256 + nc) * 512 + j];
                    pv[i][2 * sp + 1] = Pk[((size_t)sp * 4096 + bg * 256 + nc + 1) * 512 + 256 + j];
                }
            }
#pragma unroll
            for (int i = 0; i < 8; ++i) {
                const int nn = nh * 16 + ib + i, n = n0 + nn;
                float pre = bj;
#pragma unroll
                for (int sp = 0; sp < 4; ++sp) pre += bf2f(pv[i][2 * sp]) + bf2f(pv[i][2 * sp + 1]);
                const float hval = n < 255 ? pre / (1.0f + __expf(-pre)) : 0.f;
                hid[nn * 257 + j] = hval;
            }
        }
    }
    __syncthreads();
    {
        const int nn = tid >> 4, dg = tid & 15, n = n0 + nn;
        f32x4 o = {0.f, 0.f, 0.f, 0.f};
        const LAS3 float* hr = hid + nn * 257;
#pragma unroll 8
        for (int j = 0; j < 256; ++j) o += *(const LAS3 f32x4*)(w2l + j * 64 + 4 * dg) * hr[j];
        if (kv == 0) {
            *(GAS unsigned long long*)(KCMP + ((size_t)bg * 256 + n) * 64 + 4 * dg) = (unsigned long long)pk2(o[0], o[1]) | ((unsigned long long)pk2(o[2], o[3]) << 32);
        } else {
#pragma unroll
            for (int e = 0; e < 4; ++e) ((GAS bf16_t*)VCMPT)[((size_t)bg * 64 + 4 * dg + e) * 256 + n] = (bf16_t)f2bf(o[e]);
        }
    }
    __syncthreads();
}

__device__ __forceinline__ float bflo(unsigned u) { return __builtin_bit_cast(float, u << 16); }
__device__ __forceinline__ float bfhi(unsigned u) { return __builtin_bit_cast(float, u & 0xffff0000u); }
struct Q64 { u32x4 p[8]; };
__device__ __forceinline__ void load_q64(const bf16_t* qrow, Q64& q) {
#pragma unroll
    for (int c = 0; c < 8; ++c) q.p[c] = *(const __attribute__((address_space(1))) u32x4*)(qrow + c * 8);
}
__device__ __forceinline__ float dot64(const bf16_t* krow, const Q64& q) {
    float s = 0.f;
#pragma unroll
    for (int c = 0; c < 8; ++c) {
        const u32x4 v = *(const u32x4*)(krow + c * 8); const u32x4 w = q.p[c];
        s += bflo(w.x) * bflo(v.x); s += bfhi(w.x) * bfhi(v.x); s += bflo(w.y) * bflo(v.y); s += bfhi(w.y) * bfhi(v.y);
        s += bflo(w.z) * bflo(v.z); s += bfhi(w.z) * bfhi(v.z); s += bflo(w.w) * bflo(v.w); s += bfhi(w.w) * bfhi(v.w);
    }
    return s;
}
__device__ __forceinline__ float qelem(const Q64& q, int d) {
    const u32x4 w = q.p[d >> 3]; const int e = d & 7;
    const unsigned u = (e >> 1) == 0 ? w.x : (e >> 1) == 1 ? w.y : (e >> 1) == 2 ? w.z : w.w;
    return (e & 1) ? bfhi(u) : bflo(u);
}

namespace fa {
#define FA_GAS __attribute__((address_space(1)))
#define FA_LAS __attribute__((address_space(3)))
constexpr int TP = 144;
constexpr int TILE_B = 64 * TP;
constexpr int L_K0 = 0, L_V0 = 4 * TILE_B;
constexpr int L_LUT = 8 * TILE_B;
constexpr int RTN = 304, ELP = RTN + 128;
constexpr int L_KM = L_LUT + 4 * ELP * 4;
constexpr int L_SELT = L_KM + 4096;
constexpr int L_M64 = L_SELT + 2048;
constexpr int L_IMP = L_M64 + 512;
constexpr int L_ACC = L_IMP + 64 * 65 * 4;
constexpr int L_GATE = L_ACC + 6 * 8192;
constexpr int L_END = L_GATE + 4 * 3 * 64 * 2;
static_assert(L_END <= 155648 - 16, "attention LDS map");
constexpr int BIG = 1 << 30;

__device__ __forceinline__ bf16x8 pack8f(float a0, float a1, float a2, float a3, float a4, float a5, float a6, float a7) {
    u32x4 w; w.x = pg8::cvt_pk_bf16(a0, a1); w.y = pg8::cvt_pk_bf16(a2, a3); w.z = pg8::cvt_pk_bf16(a4, a5); w.w = pg8::cvt_pk_bf16(a6, a7);
    return __builtin_bit_cast(bf16x8, w);
}
template <int STRIDE>
__device__ __forceinline__ void tile_scores(f32x16& s0, f32x16& s1, const FA_LAS unsigned char* kb, const bf16x8 (&qf)[4], bool rowok, int t, int pos0, int dlim, bool constpath,
                                            const FA_LAS float* lut, int r, int hi) {
    const int kr = (r & ~12) | ((r & 4) << 1) | ((r & 8) >> 1);
    const FA_LAS unsigned char* ka = kb + kr * TP + hi * 16;
    s0 = f32x16{}; s1 = f32x16{};
#pragma unroll
    for (int s = 0; s < 4; ++s) {
        const bf16x8 a0 = *(const FA_LAS bf16x8*)(ka + s * 32);
        const bf16x8 a1 = *(const FA_LAS bf16x8*)(ka + 32 * TP + s * 32);
        s0 = __builtin_amdgcn_mfma_f32_32x32x16_bf16(a0, qf[s], s0, 0, 0, 0);
        s1 = __builtin_amdgcn_mfma_f32_32x32x16_bf16(a1, qf[s], s1, 0, 0, 0);
    }
    if (constpath) {
        const float add = rowok ? lut[127] : -INFINITY;
#pragma unroll
        for (int g = 0; g < 16; ++g) { s0[g] += add; s1[g] += add; }
    } else {
        const FA_LAS float* rt = lut - RTN;
        const int jb = 207 - (t - pos0 - STRIDE * 8 * hi);
#pragma unroll
        for (int g = 0; g < 16; ++g) {
            const int koff = (g & 7) + 16 * (g >> 3);
            { const int j = jb + STRIDE * koff; s0[g] += rt[j < 0 ? 0 : (j > RTN - 1 ? RTN - 1 : j)]; }
            { const int j = jb + STRIDE * (koff + 32); s1[g] += rt[j < 0 ? 0 : (j > RTN - 1 ? RTN - 1 : j)]; }
        }
    }
}
__device__ __forceinline__ void softmax_pv(f32x16& s0, f32x16& s1, const FA_LAS unsigned char* vb, float& m, float& l, f32x16 (&O)[2], int r, int hi) {
    float mx = fmaxf(s0[0], s1[0]);
#pragma unroll
    for (int g = 1; g < 16; ++g) mx = fmaxf(mx, fmaxf(s0[g], s1[g]));
    mx = max_x32(mx);
    const float mnew = fmaxf(m, mx);
    const float msafe = (mnew == -INFINITY) ? 0.f : mnew;
    const float alpha = __builtin_amdgcn_exp2f(m - msafe);
    m = mnew;
    float sum = 0.f;
#pragma unroll
    for (int g = 0; g < 16; ++g) { s0[g] = __builtin_amdgcn_exp2f(s0[g] - msafe); s1[g] = __builtin_amdgcn_exp2f(s1[g] - msafe); sum += s0[g] + s1[g]; }
    l = l * alpha + sum;
    if (__any(alpha != 1.0f)) { O[0] = O[0] * alpha; O[1] = O[1] * alpha; }
    const FA_LAS unsigned char* va = vb + r * TP + hi * 16;
#pragma unroll
    for (int s2 = 0; s2 < 2; ++s2) {
        const bf16x8 p0 = pack8f(s0[8 * s2 + 0], s0[8 * s2 + 1], s0[8 * s2 + 2], s0[8 * s2 + 3], s0[8 * s2 + 4], s0[8 * s2 + 5], s0[8 * s2 + 6], s0[8 * s2 + 7]);
        const bf16x8 p1 = pack8f(s1[8 * s2 + 0], s1[8 * s2 + 1], s1[8 * s2 + 2], s1[8 * s2 + 3], s1[8 * s2 + 4], s1[8 * s2 + 5], s1[8 * s2 + 6], s1[8 * s2 + 7]);
#pragma unroll
        for (int d0 = 0; d0 < 2; ++d0) {
            const bf16x8 v0 = *(const FA_LAS bf16x8*)(va + d0 * 32 * TP + s2 * 32);
            const bf16x8 v1 = *(const FA_LAS bf16x8*)(va + d0 * 32 * TP + 64 + s2 * 32);
            O[d0] = __builtin_amdgcn_mfma_f32_32x32x16_bf16(v0, p0, O[d0], 0, 0, 0);
            O[d0] = __builtin_amdgcn_mfma_f32_32x32x16_bf16(v1, p1, O[d0], 0, 0, 0);
        }
    }
}
__device__ __forceinline__ void kv_branch(FA_LAS unsigned char* L, const bf16_t* Kbase, const bf16_t* Vbase, int tau0, int tau1, const bf16x8 (&qf)[4], unsigned long long tilemask,
                                          int t, int t_wave0, int dlim, const FA_LAS float* lut, float& m, float& l, f32x16 (&O)[2], int tid, int r, int hi) {
    const int srow = tid >> 3, sch = tid & 7;
    const bf16_t* kp = Kbase + (size_t)tau0 * 4096 + srow * 64 + sch * 8;
    const bf16_t* vp = Vbase + (size_t)tau0 * 4096 + srow * 64 + sch * 8;
    const int soff = srow * TP + sch * 16;
    u32x4 kreg = *(const FA_GAS u32x4*)kp, vreg = *(const FA_GAS u32x4*)vp;
    *(FA_LAS u32x4*)(L + L_K0 + soff) = kreg; *(FA_LAS u32x4*)(L + L_V0 + soff) = vreg;
    __syncthreads();
    int buf = 0;
    for (int tau = tau0; tau <= tau1; ++tau) {
        const bool more = tau < tau1;
        if (more) { kp += 4096; vp += 4096; kreg = *(const FA_GAS u32x4*)kp; vreg = *(const FA_GAS u32x4*)vp; }
        const bool rowok = (tilemask >> tau) & 1ull;
        const int dminw = t_wave0 - (64 * tau + 63), dmaxw = t_wave0 + 31 - 64 * tau;
        if (dmaxw >= 0 && __any(rowok)) {
            f32x16 s0, s1;
            const bool constpath = dminw >= 113 && dmaxw < dlim;
            tile_scores<1>(s0, s1, L + L_K0 + buf * TILE_B, qf, rowok, t, 64 * tau, dlim, constpath, lut, r, hi);
            softmax_pv(s0, s1, L + L_V0 + buf * TILE_B, m, l, O, r, hi);
        }
        if (more) { *(FA_LAS u32x4*)(L + L_K0 + (buf ^ 1) * TILE_B + soff) = kreg; *(FA_LAS u32x4*)(L + L_V0 + (buf ^ 1) * TILE_B + soff) = vreg; }
        __syncthreads();
        buf ^= 1;
    }
}

#define FA_SBAR() __builtin_amdgcn_sched_barrier(0)
#define FA_PIN(x) asm volatile("" : "+v"(x))
#define FA_LD16(p) (*(const FA_LAS bf16x8*)(p))
constexpr float THR = 8.0f;
__device__ __forceinline__ float max3f(float a, float b, float c) { return fmaxf(fmaxf(a, b), c); }

struct BrState {
    float mhat, l;
    bf16x8 kf[4];
    u32x4 kreg, vreg; const bf16_t* kp; const bf16_t* vp;
};
template <bool WIN>
__device__ __forceinline__ void br_step(FA_LAS unsigned char* L, BrState& st, f32x16& c0, f32x16& c1, f32x16& n0, f32x16& n1, f32x16 (&O)[2], const bf16x8 (&qf)[4],
                                        unsigned long long tilemask, int i, int n, int tau, int t, int t_wave0, const FA_LAS float* elut, float cfar, int soff, int kr, int r, int hi) {
    int s_cur = i % 3, s_k2 = (i + 2) % 3, s_k1 = (i + 1) % 3;
    asm volatile("" : "+s"(s_cur), "+s"(s_k2), "+s"(s_k1));
    {
        const int dminw = t_wave0 - (64 * tau + 63), dmaxw = t_wave0 + 31 - 64 * tau;
        const bool far = dminw >= 113 && (!WIN || dmaxw < 512);
        if (!far) {
            if (WIN && dmaxw >= 512) {
                const int db = t - 64 * tau - 8 * hi;
                const float cb = cfar;
#pragma unroll
                for (int g = 0; g < 16; ++g) {
                    const int koff = (g & 7) + 16 * (g >> 3);
                    c0[g] = (db - koff < 512) ? c0[g] + cb : -INFINITY;
                    c1[g] = (db - koff - 32 < 512) ? c1[g] + cb : -INFINITY;
                }
            } else if (dmaxw < 0) {
#pragma unroll
                for (int g = 0; g < 16; ++g) { c0[g] = -INFINITY; c1[g] = -INFINITY; }
            } else {
                const FA_LAS float* rp = elut + (207 - t + 64 * tau + 8 * hi);
                asm volatile("" : "+v"(rp));
#pragma unroll
                for (int gh = 0; gh < 16; gh += 8) {
                    float ta[8], tb[8];
#pragma unroll
                    for (int k = 0; k < 8; ++k) { const int koff = ((gh + k) & 7) + 16 * ((gh + k) >> 3); ta[k] = rp[koff]; tb[k] = rp[koff + 32]; }
                    FA_SBAR();
#pragma unroll
                    for (int k = 0; k < 8; ++k) { c0[gh + k] += ta[k]; c1[gh + k] += tb[k]; }
                    FA_SBAR();
                }
            }
        }
        if (i == 0) {
            float ma = max3f(c0[0], c0[1], c1[0]), mb = max3f(c0[2], c0[3], c1[1]);
            ma = max3f(ma, c1[2], c1[3]);
#pragma unroll
            for (int g = 4; g < 16; g += 4) { ma = max3f(ma, c0[g], c0[g + 1]); mb = max3f(mb, c0[g + 2], c0[g + 3]); ma = max3f(ma, c1[g], c1[g + 1]); mb = max3f(mb, c1[g + 2], c1[g + 3]); }
            float mx = fmaxf(ma, mb);
            mx = max_x32(mx);
            const float delta = mx > -INFINITY ? mx : 0.f;
            st.mhat = delta;
#pragma unroll
            for (int g = 0; g < 16; ++g) { c0[g] -= delta; c1[g] -= delta; }
        }
    }
#if PROBE_ATT == 1
    { float dm = st.mhat; for (int k = 0; k < 32; ++k) { dm = __builtin_amdgcn_exp2f(dm); asm volatile("" : "+v"(dm)); } asm volatile("" :: "v"(dm)); }
#elif PROBE_ATT == 2
    __syncthreads();
#elif PROBE_ATT == 3
    { const FA_LAS unsigned char* pa = L + L_K0 + (r * 2 + hi) * 16; asm volatile("" : "+v"(pa)); _Pragma("unroll") for (int k = 0; k < 16; ++k) { bf16x8 d = FA_LD16(pa + k * 1024); asm volatile("" :: "v"(d)); } }
#endif
#define FA_EXP4(X, B) do { X[B] = __builtin_amdgcn_exp2f(X[B]); X[B + 1] = __builtin_amdgcn_exp2f(X[B + 1]); X[B + 2] = __builtin_amdgcn_exp2f(X[B + 2]); X[B + 3] = __builtin_amdgcn_exp2f(X[B + 3]); FA_PIN(X); } while (0)
    const FA_LAS unsigned char* va = L + L_V0 + s_cur * TILE_B + r * TP + hi * 16;
    asm volatile("" : "+v"(va));
    bf16x8 vf[4];
    {
        f32x16 cin;
        {
            const int tn = tau + 1;
            const int dminw = t_wave0 - (64 * tn + 63), dmaxw = t_wave0 + 31 - 64 * tn;
            const bool far = dminw >= 113 && (!WIN || dmaxw < 512);
            const float cval = ((tilemask >> tn) & 1ull) ? (far ? cfar : 0.f) - st.mhat : -INFINITY;
#pragma unroll
            for (int g = 0; g < 16; ++g) cin[g] = cval;
        }
        const FA_LAS unsigned char* kb = L + L_K0 + s_k1 * TILE_B + kr * TP + hi * 16;
        asm volatile("" : "+v"(kb));
        bf16x8 kg[4];
        FA_SBAR();
#pragma unroll
        for (int j = 0; j < 8; ++j) {
            const int s = j >> 1;
            const bf16x8 kfrag = j < 4 ? st.kf[j] : kg[j - 4];
            if ((j & 1) == 0) n0 = __builtin_amdgcn_mfma_f32_32x32x16_bf16(kfrag, qf[s], s == 0 ? cin : n0, 0, 0, 0);
            else              n1 = __builtin_amdgcn_mfma_f32_32x32x16_bf16(kfrag, qf[s], s == 0 ? cin : n1, 0, 0, 0);
            if (j < 4) FA_EXP4(c0, 4 * j); else FA_EXP4(c1, 4 * (j - 4));
            if (j < 4) kg[j] = FA_LD16(kb + (j & 1) * 32 * TP + ((4 + j) >> 1) * 32);
            else vf[j - 4] = FA_LD16(va + (j & 1) * 32 * TP + ((j - 4) >> 2) * 64 + (((j - 4) >> 1) & 1) * 32);
            FA_SBAR();
        }
    }
#undef FA_EXP4
    {
        const FA_LAS unsigned char* ka = L + L_K0 + s_k2 * TILE_B + kr * TP + hi * 16;
        asm volatile("" : "+v"(ka));
        const bool more2 = i + 2 < n;
        float ls = 0.f;
        bf16x8 pk, vg[4];
        FA_SBAR();
#pragma unroll
        for (int j = 0; j < 8; ++j) {
            const int p = j >> 1, b = 8 * (p & 1);
            const f32x16& S = (p >> 1) ? c1 : c0;
            const bf16x8 vfrag = j < 4 ? vf[j] : vg[j - 4];
            if ((j & 1) == 0) {
                pk = pack8f(S[b], S[b + 1], S[b + 2], S[b + 3], S[b + 4], S[b + 5], S[b + 6], S[b + 7]);
                O[0] = __builtin_amdgcn_mfma_f32_32x32x16_bf16(vfrag, pk, O[0], 0, 0, 0);
                ls += (S[b] + S[b + 1]) + (S[b + 2] + S[b + 3]); FA_PIN(ls);
            } else {
                O[1] = __builtin_amdgcn_mfma_f32_32x32x16_bf16(vfrag, pk, O[1], 0, 0, 0);
                ls += (S[b + 4] + S[b + 5]) + (S[b + 6] + S[b + 7]); FA_PIN(ls);
            }
            if (j < 4) vg[j] = FA_LD16(va + (j & 1) * 32 * TP + ((4 + j) >> 2) * 64 + (((4 + j) >> 1) & 1) * 32);
            else if (more2) st.kf[j - 4] = FA_LD16(ka + (j & 1) * 32 * TP + ((j - 4) >> 1) * 32);
            FA_SBAR();
        }
        st.l += ls;
    }
    if (i + 3 < n) *(FA_LAS u32x4*)(L + L_K0 + s_cur * TILE_B + soff) = st.kreg;
    if (i + 2 < n) *(FA_LAS u32x4*)(L + L_V0 + s_k2 * TILE_B + soff) = st.vreg;
    if (i + 4 < n) { st.kp += 4096; st.kreg = *(const FA_GAS u32x4*)st.kp; }
    if (i + 3 < n) { st.vp += 4096; st.vreg = *(const FA_GAS u32x4*)st.vp; }
    __syncthreads();
}
struct BrPre { u32x4 k0, v0, k1, v1, k2, v2, k3; };
__device__ __forceinline__ void br_preload(BrPre& p, const bf16_t* Kbase, const bf16_t* Vbase, int tau0, int n, int tid) {
    const int srow = tid >> 3, sch = tid & 7;
    const bf16_t* kp = Kbase + (size_t)tau0 * 4096 + srow * 64 + sch * 8;
    const bf16_t* vp = Vbase + (size_t)tau0 * 4096 + srow * 64 + sch * 8;
    p.k0 = *(const FA_GAS u32x4*)kp; p.v0 = *(const FA_GAS u32x4*)vp;
    p.k1 = p.k0; p.v1 = p.v0; p.k2 = p.k0; p.v2 = p.v0; p.k3 = p.k0;
    if (n > 1) { p.k1 = *(const FA_GAS u32x4*)(kp + 4096); p.v1 = *(const FA_GAS u32x4*)(vp + 4096); }
    if (n > 2) { p.k2 = *(const FA_GAS u32x4*)(kp + 2 * 4096); p.v2 = *(const FA_GAS u32x4*)(vp + 2 * 4096); }
    if (n > 3) p.k3 = *(const FA_GAS u32x4*)(kp + 3 * 4096);
}
template <bool WIN, bool PRE = false>
__device__ __forceinline__ void kv_branch2(FA_LAS unsigned char* L, const bf16_t* Kbase, const bf16_t* Vbase, int tau0, int tau1, const bf16x8 (&qf)[4], unsigned long long tilemask,
                                           int t, int t_wave0, const FA_LAS float* elut, float& l, f32x16 (&O)[2], int tid_in, BrPre& pre) {
    int tid = tid_in; asm volatile("" : "+v"(tid));
    const int r = tid & 31, hi = (tid >> 5) & 1;
    const int n = tau1 - tau0 + 1;
    const int srow = tid >> 3, sch = tid & 7, soff = srow * TP + sch * 16;
    const int kr = (r & ~12) | ((r & 4) << 1) | ((r & 8) >> 1);
    const float cfar = __builtin_bit_cast(float, __builtin_amdgcn_readfirstlane(__builtin_bit_cast(int, elut[0])));
    BrState st;
    st.kp = Kbase + (size_t)tau0 * 4096 + srow * 64 + sch * 8;
    st.vp = Vbase + (size_t)tau0 * 4096 + srow * 64 + sch * 8;
    {
        if constexpr (!PRE) br_preload(pre, Kbase, Vbase, tau0, n, tid);
        st.vreg = pre.v2; st.kreg = pre.k3;
        st.kp += (n > 3 ? 3 : n > 2 ? 2 : n > 1 ? 1 : 0) * 4096; st.vp += (n > 2 ? 2 : n > 1 ? 1 : 0) * 4096;
        *(FA_LAS u32x4*)(L + L_K0 + soff) = pre.k0; *(FA_LAS u32x4*)(L + L_V0 + soff) = pre.v0;
        if (n > 1) { *(FA_LAS u32x4*)(L + L_K0 + TILE_B + soff) = pre.k1; *(FA_LAS u32x4*)(L + L_V0 + TILE_B + soff) = pre.v1; }
        if (n > 2) *(FA_LAS u32x4*)(L + L_K0 + 2 * TILE_B + soff) = pre.k2;
    }
    __syncthreads();
    st.mhat = 0.f; st.l = 0.f; O[0] = f32x16{}; O[1] = f32x16{};
    f32x16 A0, A1, B0, B1;
    {
        const int dminw = t_wave0 - (64 * tau0 + 63), dmaxw = t_wave0 + 31 - 64 * tau0;
        const bool far = dminw >= 113 && (!WIN || dmaxw < 512);
        const float cval = ((tilemask >> tau0) & 1ull) ? (far ? cfar : 0.f) : -INFINITY;
        f32x16 cin;
#pragma unroll
        for (int g = 0; g < 16; ++g) cin[g] = cval;
        const FA_LAS unsigned char* ka = L + L_K0 + kr * TP + hi * 16;
        asm volatile("" : "+v"(ka));
#pragma unroll
        for (int s = 0; s < 4; ++s) {
            A0 = __builtin_amdgcn_mfma_f32_32x32x16_bf16(FA_LD16(ka + s * 32), qf[s], s == 0 ? cin : A0, 0, 0, 0);
            A1 = __builtin_amdgcn_mfma_f32_32x32x16_bf16(FA_LD16(ka + 32 * TP + s * 32), qf[s], s == 0 ? cin : A1, 0, 0, 0);
        }
        if (n > 1) {
#pragma unroll
            for (int j = 0; j < 4; ++j) st.kf[j] = FA_LD16(ka + TILE_B + (j & 1) * 32 * TP + (j >> 1) * 32);
        }
    }
    __syncthreads();
    int i = 0;
    for (; i + 1 < n; i += 2) {
        br_step<WIN>(L, st, A0, A1, B0, B1, O, qf, tilemask, i, n, tau0 + i, t, t_wave0, elut, cfar, soff, kr, r, hi);
        br_step<WIN>(L, st, B0, B1, A0, A1, O, qf, tilemask, i + 1, n, tau0 + i + 1, t, t_wave0, elut, cfar, soff, kr, r, hi);
    }
    if (i < n) br_step<WIN>(L, st, A0, A1, B0, B1, O, qf, tilemask, i, n, tau0 + i, t, t_wave0, elut, cfar, soff, kr, r, hi);
    l = st.l;
}

__device__ __forceinline__ void build_lut(FA_LAS float* elut, const float* elutg  , int col0, int nheads, int tid) {
    for (int i = tid; i < nheads * ELP; i += 512) elut[i] = ((const FA_GAS float*)elutg)[col0 * ELP + i];
}
__device__ __forceinline__ void store_ot(const f32x16 (&O)[2], float scale, bf16_t* orow) {
#pragma unroll
    for (int d0 = 0; d0 < 2; ++d0)
#pragma unroll
        for (int gq = 0; gq < 4; ++gq) {
            const unsigned lo = pg8::cvt_pk_bf16(O[d0][4 * gq] * scale, O[d0][4 * gq + 1] * scale), hi2 = pg8::cvt_pk_bf16(O[d0][4 * gq + 2] * scale, O[d0][4 * gq + 3] * scale);
            *(FA_GAS unsigned long long*)(orow + 32 * d0 + 8 * gq) = (unsigned long long)lo | ((unsigned long long)hi2 << 32);
        }
}

__device__ __forceinline__ void moba_unit(unsigned char* ldsg, int b, int h, int cur, const bf16_t* QA, const bf16_t* KA, const bf16_t* VT, const float* KMEAN, const float* relb, bf16_t* Oout, int wave_in) {
    FA_LAS unsigned char* L = (FA_LAS unsigned char*)ldsg;
    unsigned zero_v_; asm volatile("v_mov_b32 %0, 0" : "=v"(zero_v_));
    const int lane = (int)__builtin_amdgcn_mbcnt_hi(~0u, __builtin_amdgcn_mbcnt_lo(~0u, zero_v_)), w = wave_in, r = lane & 31, hi = lane >> 5;
    const int tid = w * 64 + lane;
    const int bh = b * 8 + h;
    FA_LAS float* lut = (FA_LAS float*)(L + L_LUT);
    FA_LAS float* km = (FA_LAS float*)(L + L_KM);
    FA_LAS unsigned long long* selt = (FA_LAS unsigned long long*)(L + L_SELT);
    __syncthreads();
    BrPre pre; br_preload(pre, KA + (size_t)bh * SEQ * 64, VT + VT_VA + (size_t)bh * 64 * 4096, 0, 4 * cur + 4, tid);
    Q64 qq; load_q64(QA + ((size_t)bh * SEQ + 256 * cur + (tid >> 1)) * 64, qq);
    const int tq = 256 * cur + 32 * w + r;
    bf16x8 qf[4];
    {
        const bf16_t* qrow = QA + ((size_t)bh * SEQ + tq) * 64 + 8 * hi;
#pragma unroll
        for (int s = 0; s < 4; ++s) qf[s] = *(const FA_GAS bf16x8*)(qrow + 16 * s);
    }
    build_lut(lut, relb, h, 1, tid);
    { const FA_GAS float* src = (const FA_GAS float*)(KMEAN + (size_t)bh * 1024); km[tid] = src[tid]; km[tid + 512] = src[tid + 512]; }
    __syncthreads();
    {
        const int q = tid >> 1, half = tid & 1;
        FA_LAS float* gsh = (FA_LAS float*)(L + L_V0) + q * 20;
        {
            float qv[64];
#pragma unroll
            for (int d = 0; d < 64; ++d) qv[d] = qelem(qq, d);
#pragma unroll 1
            for (int i = 0; i < 8; ++i) {
                const int j = half * 8 + i;
                float s = -INFINITY;
                if (j < cur) {
                    float s0 = 0.f, s1 = 0.f;
#pragma unroll
                    for (int d = 0; d < 64; d += 4) { const f32x4 kk = *(const FA_LAS f32x4*)(km + j * 64 + d); s0 += qv[d] * kk[0]; s1 += qv[d + 1] * kk[1]; s0 += qv[d + 2] * kk[2]; s1 += qv[d + 3] * kk[3]; }
                    s = s0 + s1;
                }
                gsh[j] = s;
            }
        }
        asm volatile("s_waitcnt lgkmcnt(0)" ::: "memory");
        float ga[16];
#pragma unroll
        for (int j4 = 0; j4 < 4; ++j4) { const f32x4 v = *(const FA_LAS f32x4*)(gsh + 4 * j4); ga[4 * j4] = v[0]; ga[4 * j4 + 1] = v[1]; ga[4 * j4 + 2] = v[2]; ga[4 * j4 + 3] = v[3]; }
        unsigned key[16];
#pragma unroll
        for (int j = 0; j < 16; ++j) { const unsigned u = __builtin_bit_cast(unsigned, ga[j]); const unsigned s = (u & 0x80000000u) ? ~u : (u | 0x80000000u); key[j] = (s & ~15u) | (unsigned)(15 - j); }
        unsigned bits = 0u;
#pragma unroll
        for (int i = 0; i < 8; ++i) {
            unsigned ka_ = key[i], kb_ = key[8 + i]; asm volatile("" : "+v"(ka_), "+v"(kb_));
            const unsigned kj = half ? kb_ : ka_;
            int rank = 0;
#pragma unroll
            for (int i2 = 0; i2 < 16; ++i2) rank += (key[i2] > kj) ? 1 : 0;
            if (half * 8 + i < cur && rank < 3) bits |= 1u << (half * 8 + i);
        }
        bits |= (unsigned)__builtin_amdgcn_ds_swizzle((int)bits, (1 << 10) | 0x1f);
        unsigned long long tm = 0xFull << (4 * cur);
#pragma unroll
        for (int j = 0; j < 16; ++j) if ((bits >> j) & 1u) tm |= 0xFull << (4 * j);
        if (half == 0) selt[q] = tm;
    }
    __syncthreads();
    const unsigned long long tm = selt[32 * w + r];
    float l = 0.f; f32x16 O[2];
    kv_branch2<false, true>(L, KA + (size_t)bh * SEQ * 64, VT + VT_VA + (size_t)bh * 64 * 4096, 0, 4 * cur + 3, qf, tm, tq, 256 * cur + 32 * w, lut, l, O, tid, pre);
    l = sum_x32(l);
    store_ot(O, 1.0f / l, Oout + ((size_t)b * SEQ + tq) * XLD + h * 64 + 4 * hi);
}

__device__ __forceinline__ void nsa_unit(unsigned char* ldsg, int b, int g, int c, const bf16_t* QB, const bf16_t* KCMP, const bf16_t* VCMPT, const bf16_t* KS, const bf16_t* KW, const bf16_t* VT,
                                         const float* relb, bf16_t* Oout, int wave_in) {
    FA_LAS unsigned char* L = (FA_LAS unsigned char*)ldsg;
    unsigned zero_v_; asm volatile("v_mov_b32 %0, 0" : "=v"(zero_v_));
    const int lane = (int)__builtin_amdgcn_mbcnt_hi(~0u, __builtin_amdgcn_mbcnt_lo(~0u, zero_v_)), w = wave_in, r = lane & 31, hi = lane >> 5;
    const int tid = w * 64 + lane;
    const int rh = w >> 1, qh = w & 1, hh = 4 * g + rh, bg = b * 2 + g;
    FA_LAS float* lutall = (FA_LAS float*)(L + L_LUT);
    FA_LAS unsigned* imp = (FA_LAS unsigned*)(L + L_IMP);
    FA_LAS unsigned long long* m64 = (FA_LAS unsigned long long*)(L + L_M64);
    const int nc = (4 * c + 3 + 63) >> 6;
    __syncthreads();
    build_lut(lutall, relb, 8 + 4 * g, 4, tid);
    for (int i = tid; i < 64 * 65; i += 512) imp[i] = 0u;
    if (tid < 96) {
        const int grow = tid >> 3, gch = tid & 7;
        *(FA_LAS u32x4*)(L + L_GATE + grow * 128 + gch * 16) = *(const FA_GAS u32x4*)(VT + VT_G + (size_t)(12 * g + grow) * MTOK + (size_t)b * SEQ + 64 * c + gch * 8);
    }
    {
        const int srow = tid >> 3, sch = tid & 7, soff = srow * TP + sch * 16;
        u32x4 kk[4], vv[4];
#pragma unroll
        for (int tau = 0; tau < 4; ++tau) if (tau < nc) {
            kk[tau] = *(const FA_GAS u32x4*)(KCMP + ((size_t)bg * 256 + 64 * tau + srow) * 64 + sch * 8);
            vv[tau] = *(const FA_GAS u32x4*)(VCMPT + ((size_t)bg * 64 + srow) * 256 + 64 * tau + sch * 8);
        }
#pragma unroll
        for (int tau = 0; tau < 4; ++tau) if (tau < nc) {
            *(FA_LAS u32x4*)(L + L_K0 + tau * TILE_B + soff) = kk[tau];
            *(FA_LAS u32x4*)(L + L_V0 + tau * TILE_B + soff) = vv[tau];
        }
    }
    __syncthreads();
    const int tq = 64 * c + 32 * qh + r, tw0 = 64 * c + 32 * qh;
    const FA_LAS float* elut = lutall + rh * ELP;
    const FA_LAS float* lut = elut + RTN;
    bf16x8 qf[4];
    {
        const bf16_t* qrow = QB + ((size_t)(b * 8 + hh) * SEQ + tq) * 64 + 8 * hi;
#pragma unroll
        for (int s = 0; s < 4; ++s) qf[s] = *(const FA_GAS bf16x8*)(qrow + 16 * s);
    }
#define NSA_FRESH unsigned z2_; asm volatile("v_mov_b32 %0, 0" : "=v"(z2_)); const int lane2 = (int)__builtin_amdgcn_mbcnt_hi(~0u, __builtin_amdgcn_mbcnt_lo(~0u, z2_)); \
    const int tokcol = b * SEQ + 64 * c + 32 * qh + (lane2 & 31); const int hi2 = lane2 >> 5; (void)hi2; \
    FA_LAS f32x4* accp = (FA_LAS f32x4*)(L + (w == 0 ? L_K0 + 3 * TILE_B : w == 1 ? L_V0 + 3 * TILE_B : L_ACC + (w - 2) * 8192)) + lane2; (void)accp; (void)tokcol;
    float l = 0.f; f32x16 O[2];
    {
        f32x16 S[4][2];
#pragma unroll
        for (int tau = 0; tau < 4; ++tau) {
            if (tau < nc && 1024 * tau + 31 <= tw0 + 31) {
                tile_scores<16>(S[tau][0], S[tau][1], L + L_K0 + tau * TILE_B, qf, true, tq, 1024 * tau + 31, BIG, false, lut, r, hi);
            } else {
#pragma unroll
                for (int g = 0; g < 16; ++g) { S[tau][0][g] = -INFINITY; S[tau][1][g] = -INFINITY; }
            }
        }
        float mx = -INFINITY;
#pragma unroll
        for (int tau = 0; tau < 4; ++tau)
#pragma unroll
            for (int g = 0; g < 16; ++g) mx = max3f(mx, S[tau][0][g], S[tau][1][g]);
        mx = max_x32(mx);
        const float msafe = (mx == -INFINITY) ? 0.f : mx;
        float sum = 0.f;
#pragma unroll
        for (int tau = 0; tau < 4; ++tau) {
            if (tau < nc) {
#pragma unroll
                for (int g = 0; g < 16; ++g) { S[tau][0][g] = __builtin_amdgcn_exp2f(S[tau][0][g] - msafe); S[tau][1][g] = __builtin_amdgcn_exp2f(S[tau][1][g] - msafe); sum += S[tau][0][g]; FA_PIN(sum); sum += S[tau][1][g]; FA_PIN(sum); }
            }
        }
        const float lt = sum_x32(sum);
        const float inv = lt > 0.f ? 1.0f / lt : 0.f;
        l = lt;
        if (c >= 16) {
            FA_LAS unsigned* improw = imp + (32 * qh + r) * 65;
            float fx = 1048576.0f; asm volatile("" : "+v"(fx));
            const float invf = inv * fx;
#pragma unroll
            for (int tau = 0; tau < 4; ++tau) {
                if (tau < nc) {
#pragma unroll
                    for (int kt = 0; kt < 2; ++kt)
#pragma unroll
                        for (int gq = 0; gq < 4; ++gq) {
                            const f32x16& s = S[tau][kt];
                            float p0 = s[4 * gq] * invf, p1 = s[4 * gq + 1] * invf, p2 = s[4 * gq + 2] * invf, p3 = s[4 * gq + 3] * invf;
                            FA_PIN(p0); FA_PIN(p1); FA_PIN(p2); FA_PIN(p3);
                            const int j = 16 * tau + 8 * kt + (gq & 1) + 2 * hi + 4 * (gq >> 1);
                            const unsigned ua = (unsigned)((p0 + 2.0f * (p1 + p2 + p3)) + 0.5f), ub = (unsigned)(p0 + 0.5f);
                            if (ua) __atomic_fetch_add(improw + j, ua, __ATOMIC_RELAXED);
                            if (ub && j >= 1) __atomic_fetch_add(improw + j - 1, ub, __ATOMIC_RELAXED);
                        }
                }
            }
        }
        O[0] = f32x16{}; O[1] = f32x16{};
#pragma unroll
        for (int tau = 0; tau < 4; ++tau) {
            if (tau < nc) {
                const FA_LAS unsigned char* va = L + L_V0 + tau * TILE_B + r * TP + hi * 16;
#pragma unroll
                for (int s2 = 0; s2 < 2; ++s2) {
                    const f32x16& s0 = S[tau][0]; const f32x16& s1 = S[tau][1];
                    const bf16x8 p0 = pack8f(s0[8 * s2 + 0], s0[8 * s2 + 1], s0[8 * s2 + 2], s0[8 * s2 + 3], s0[8 * s2 + 4], s0[8 * s2 + 5], s0[8 * s2 + 6], s0[8 * s2 + 7]);
                    const bf16x8 p1 = pack8f(s1[8 * s2 + 0], s1[8 * s2 + 1], s1[8 * s2 + 2], s1[8 * s2 + 3], s1[8 * s2 + 4], s1[8 * s2 + 5], s1[8 * s2 + 6], s1[8 * s2 + 7]);
#pragma unroll
                    for (int d0 = 0; d0 < 2; ++d0) {
                        O[d0] = __builtin_amdgcn_mfma_f32_32x32x16_bf16(FA_LD16(va + d0 * 32 * TP + s2 * 32), p0, O[d0], 0, 0, 0);
                        O[d0] = __builtin_amdgcn_mfma_f32_32x32x16_bf16(FA_LD16(va + d0 * 32 * TP + 64 + s2 * 32), p1, O[d0], 0, 0, 0);
                    }
                }
            }
        }
        NSA_FRESH
        const float g0 = bf2f(((const FA_LAS bf16_t*)(L + L_GATE))[(rh * 3 + 0) * 64 + 32 * qh + (lane2 & 31)]);
        const float sc0 = g0 * inv;
        O[0] = O[0] * sc0; O[1] = O[1] * sc0;
    }
    BrPre pre; br_preload(pre, KS + (size_t)bg * SEQ * 64, VT + VT_VS + (size_t)bg * 64 * 4096, 0, c + 1, tid);
    __syncthreads();
    { NSA_FRESH
#pragma unroll
    for (int k4 = 0; k4 < 4; ++k4) { accp[k4 * 64] = (f32x4){O[0][4 * k4], O[0][4 * k4 + 1], O[0][4 * k4 + 2], O[0][4 * k4 + 3]}; accp[(4 + k4) * 64] = (f32x4){O[1][4 * k4], O[1][4 * k4 + 1], O[1][4 * k4 + 2], O[1][4 * k4 + 3]}; } }
    if (c >= 16) {
        const int q = tid >> 3, jj = tid & 7;
        const FA_LAS unsigned* row = imp + q * 65;
        FA_LAS unsigned* roww = imp + q * 65;
        unsigned sc[8]; int rank[8];
#pragma unroll
        for (int i = 0; i < 8; ++i) {
            const int j = jj * 8 + i;
            const unsigned v = (j == 0 || j == c || j == c - 1) ? 0xFFFFFFC0u : (roww[j] << 6);
            sc[i] = v | (unsigned)(63 - j); rank[i] = 0;
            roww[j] = sc[i];
        }
        asm volatile("s_waitcnt lgkmcnt(0)" ::: "memory");
        for (int i2 = 0; i2 <= c; ++i2) {
            const unsigned v = row[i2];
#pragma unroll
            for (int i = 0; i < 8; ++i) rank[i] += (v > sc[i]) ? 1 : 0;
        }
        unsigned bits = 0u;
#pragma unroll
        for (int i = 0; i < 8; ++i) if (jj * 8 + i <= c && rank[i] < 16) bits |= 1u << i;
        ((FA_LAS unsigned char*)m64)[q * 8 + jj] = (unsigned char)bits;
    } else if (tid < 64) {
        m64[tid] = (2ull << c) - 1ull;
    }
    __syncthreads();
    const unsigned long long tm = m64[32 * qh + r];
    kv_branch2<false, true>(L, KS + (size_t)bg * SEQ * 64, VT + VT_VS + (size_t)bg * 64 * 4096, 0, c, qf, tm, tq, tw0, elut, l, O, tid, pre);
    br_preload(pre, KW + (size_t)bg * SEQ * 64, VT + VT_VW + (size_t)bg * 64 * 4096, c >= 8 ? c - 8 : 0, c >= 8 ? 9 : c + 1, tid);
    {
        const float lt = sum_x32(l);
        NSA_FRESH
        const float g1 = bf2f(((const FA_LAS bf16_t*)(L + L_GATE))[(rh * 3 + 1) * 64 + 32 * qh + (lane2 & 31)]);
        const float sc = g1 / lt;
#pragma unroll
        for (int k4 = 0; k4 < 4; ++k4) {
            f32x4 a0 = accp[k4 * 64], a1 = accp[(4 + k4) * 64];
#pragma unroll
            for (int e = 0; e < 4; ++e) { a0[e] += O[0][4 * k4 + e] * sc; a1[e] += O[1][4 * k4 + e] * sc; }
            accp[k4 * 64] = a0; accp[(4 + k4) * 64] = a1;
        }
    }
    kv_branch2<true, true>(L, KW + (size_t)bg * SEQ * 64, VT + VT_VW + (size_t)bg * 64 * 4096, c >= 8 ? c - 8 : 0, c, qf, ~0ull, tq, tw0, elut, l, O, tid, pre);
    {
        const float lt = sum_x32(l);
        NSA_FRESH
        const float g2 = bf2f(((const FA_LAS bf16_t*)(L + L_GATE))[(rh * 3 + 2) * 64 + 32 * qh + (lane2 & 31)]);
        const float sc = g2 / lt;
#pragma unroll
        for (int k4 = 0; k4 < 4; ++k4) {
            const f32x4 a0 = accp[k4 * 64], a1 = accp[(4 + k4) * 64];
#pragma unroll
            for (int e = 0; e < 4; ++e) { O[0][4 * k4 + e] = a0[e] + O[0][4 * k4 + e] * sc; O[1][4 * k4 + e] = a1[e] + O[1][4 * k4 + e] * sc; }
        }
        store_ot(O, 1.0f, Oout + (size_t)tokcol * XLD + 512 + hh * 64 + 4 * hi2);
    }
#undef NSA_FRESH
}
}

#define XB_TMO      128
#define XB_XCNT(j)  (256  + 64 * (j))
#define XB_XSUB(j)  (1280 + 64 * (j))
#define XB_XGEN(j)  (2304 + 64 * (j))
#define XB_TOP      3328
#define XB_TOPGEN   3392
#define XB_DONE     3456
#define XCD_BAR_WORDS 3520
#define XB_SPIN_CAP (1u << 18)

__device__ __forceinline__ unsigned xb_ld(unsigned* p)              { return __hip_atomic_load(p, __ATOMIC_RELAXED, __HIP_MEMORY_SCOPE_AGENT); }
__device__ __forceinline__ unsigned xb_add(unsigned* p, unsigned v) { return __hip_atomic_fetch_add(p, v, __ATOMIC_RELAXED, __HIP_MEMORY_SCOPE_AGENT); }
__device__ __forceinline__ unsigned xb_xcc_id() { return (unsigned)__builtin_amdgcn_s_getreg((3 << 11) | 20) & 0xFu; }
#define XB_SPIN(cond, bar) do { unsigned _sp = 0; while (cond) { __builtin_amdgcn_s_sleep(1); \
    if ((++_sp & 255u) == 0u) { if (xb_ld(&(bar)[XB_TMO])) break; if (_sp > XB_SPIN_CAP) { atomicAdd(&(bar)[XB_TMO], 1u); break; } } } } while (0)

struct XcdBarrier {
    unsigned* bar; unsigned x;
    volatile __attribute__((address_space(3))) unsigned* st;
};

__device__ __forceinline__ XcdBarrier xcd_barrier_post(unsigned* bar, volatile __attribute__((address_space(3))) unsigned* st) {
    XcdBarrier b; b.bar = bar; b.x = xb_xcc_id(); b.st = st;
    if (threadIdx.x == 0) (void)xb_add(&bar[XB_XCNT(b.x)], 1u);
    return b;
}
__device__ __forceinline__ void xcd_barrier_complete(unsigned* bar, unsigned x, unsigned& nloc, unsigned& nx) {
    const unsigned G = gridDim.x * gridDim.y * gridDim.z;
    unsigned sum, cnt, mine, sp = 0u;
    for (;;) {
        sum = 0u; cnt = 0u; mine = 0u;
#pragma unroll
        for (unsigned j = 0; j < 16; ++j) { const unsigned c = xb_ld(&bar[XB_XCNT(j)]); sum += c; cnt += (c > 0u) ? 1u : 0u; mine = (j == x) ? c : mine; }
        if (sum == G) break;
        __builtin_amdgcn_s_sleep(1);
        if ((++sp & 255u) == 0u) { if (xb_ld(&bar[XB_TMO])) break; if (sp > XB_SPIN_CAP) { atomicAdd(&bar[XB_TMO], 1u); break; } }
    }
    nloc = mine > 0u ? mine : 1u; nx = cnt > 0u ? cnt : 1u;
}

__device__ __forceinline__ void xcd_barrier(const XcdBarrier& b) {
    asm volatile("s_waitcnt vmcnt(0)" ::: "memory");
    __syncthreads();
    if (threadIdx.x == 0) {
        unsigned* bar = b.bar;
        __builtin_amdgcn_s_waitcnt(0);
        unsigned nloc = b.st[0], nx = b.st[1];
        if (nloc == 0u) { xcd_barrier_complete(bar, b.x, nloc, nx); b.st[0] = nloc; b.st[1] = nx; }
        const unsigned old = xb_add(&bar[XB_XSUB(b.x)], 1u);
        const unsigned gen = old / nloc;
        if (old + 1u == (gen + 1u) * nloc) {
            __builtin_amdgcn_fence(__ATOMIC_RELEASE, "agent");
            asm volatile("s_waitcnt vmcnt(0)" ::: "memory");
            const unsigned og = xb_add(&bar[XB_TOP], 1u);
            const unsigned tg = og / nx;
            if (og + 1u == (tg + 1u) * nx) xb_add(&bar[XB_TOPGEN], 1u);
            else XB_SPIN(xb_ld(&bar[XB_TOPGEN]) == tg, bar);
            __builtin_amdgcn_fence(__ATOMIC_ACQUIRE, "agent");
            xb_add(&bar[XB_XGEN(b.x)], 1u);
            asm volatile("s_waitcnt vmcnt(0)" ::: "memory");
        } else {
            XB_SPIN(xb_ld(&bar[XB_XGEN(b.x)]) == gen, bar);
            __builtin_amdgcn_fence(__ATOMIC_ACQUIRE, "agent");
            asm volatile("s_waitcnt vmcnt(0)" ::: "memory");
        }
    }
    __syncthreads();
}

#ifndef PROBE_REPEAT
#define PROBE_REPEAT (-1)
#endif
#ifndef PROBE_EMPTY
#define PROBE_EMPTY 0
#endif
constexpr int NPHASE = 11 + (PROBE_REPEAT >= 0 ? 1 : 0) + PROBE_EMPTY;
constexpr int LDS_BYTES = 155648;

__global__ void __launch_bounds__(512, 2) mega(MegaArgs a) {
    extern __shared__ __attribute__((aligned(16))) unsigned char lds[];
    unsigned char* ws = a.ws; float* out = a.out;
    const int G_s = (int)gridDim.x;
    const int wave_s = __builtin_amdgcn_readfirstlane((int)threadIdx.x >> 6);
    volatile __attribute__((address_space(3))) unsigned* bar_st = (volatile __attribute__((address_space(3))) unsigned*)((__attribute__((address_space(3))) unsigned char*)lds + (LDS_BYTES - 16));
    if (threadIdx.x < 2) bar_st[threadIdx.x] = 0u;
    __syncthreads();
    (void)xcd_barrier_post((unsigned*)(a.ws + WS_BAR), bar_st);
    for (int ph0 = a.ph_lo; ph0 < a.ph_hi; ++ph0) {
        const int ph = (PROBE_REPEAT >= 0 && ph0 > PROBE_REPEAT) ? ph0 - 1 : ph0;
        int wave = wave_s, G = G_s, bx = (int)blockIdx.x; asm volatile("" : "+s"(wave), "+s"(ws), "+s"(out), "+s"(G), "+s"(bx));
        const int gw = bx * 8 + wave, ngw = G * 8;
#define LANE_TID unsigned zero_v_; asm volatile("v_mov_b32 %0, 0" : "=v"(zero_v_)); const int lane = (int)__builtin_amdgcn_mbcnt_hi(~0u, __builtin_amdgcn_mbcnt_lo(~0u, zero_v_)); const int tid = wave * 64 + lane; (void)tid;
        bf16_t* XB = (bf16_t*)(ws + WS_XB); bf16_t* H = (bf16_t*)(ws + WS_H); bf16_t* VT = (bf16_t*)(ws + WS_VT); bf16_t* O = (bf16_t*)(ws + WS_O);
        float* SSP = (float*)(ws + WS_SSPART);
        PG8_LAS unsigned char* glds = (PG8_LAS unsigned char*)lds;
        if (ph == 0) {
            LANE_TID
            ph_prep(a, (LAS3 float*)lds + wave * (64 * 33), gw, ngw, lane);
            for (int row = gw; row < MTOK; row += 2 * ngw) rownorm_row2(a.in[0], XB, SSP, row, row + ngw, lane);
        } else if (ph == 1 || ph == 8) {
            LANE_TID
            pg8::Gemm g{XB, (const bf16_t*)(ws + (ph == 1 ? WS_WGU1 : WS_WGU2)), MTOK, 2 * DFF, DM, XLD, 0};
            pg8::StaticOrder S; S.init(MTOK, 2 * DFF, G, bx);
            PG8_LAS float* rcache = (PG8_LAS float*)(glds + pg8::STAGE_BYTES);
            rcache[tid * 9] = __builtin_bit_cast(float, -1);
            pg8::EpiSwigluF E{H, SSP, rcache};
#if STAGGER
            for (int k = 0; k < (bx & 7); ++k) __builtin_amdgcn_s_sleep(75);
#endif
            pg8::gemm_phase<pg8::EpiSwigluF, pg8::StaticOrder, true, true>(glds, g, S, E, tid);
#if PROBE_GEMM == 1
            if (ph == 1) { pg8::EpiNullF EN{0, 0}; pg8::gemm_phase<pg8::EpiNullF, pg8::StaticOrder, true, true>(glds, g, S, EN, tid); }
#elif PROBE_GEMM == 3
            if (ph == 1) { pg8::Gemm g2{H, (const bf16_t*)(ws + WS_WD1), MTOK, DM, DFF, 0, 0}; pg8::StaticOrder S2; S2.init(MTOK, DM, G, bx); pg8::EpiResidF E2{nullptr, (bf16_t*)(ws + WS_O), (float*)(ws + WS_VT), 0.5f, 0}; pg8::gemm_phase<pg8::EpiResidF, pg8::StaticOrder, true, true>(glds, g2, S2, E2, tid); }
#elif PROBE_GEMM == 4 || PROBE_GEMM == 5
            if (ph == 1) { pg8::Gemm g2{H, (const bf16_t*)(ws + WS_WD1), MTOK, DM, DFF, 0, 0}; pg8::StaticOrder S2; S2.init(MTOK, DM, G, bx); pg8::EpiResidF E2{nullptr, (bf16_t*)(ws + WS_O), (float*)(ws + WS_VT), 0.5f, PROBE_GEMM == 4 ? 1 : 2}; pg8::gemm_phase<pg8::EpiResidF, pg8::StaticOrder, true, true>(glds, g2, S2, E2, tid); }
#elif PROBE_GEMM == 2
            if (ph == 1) { pg8::Gemm g2{H, (const bf16_t*)(ws + WS_WD1), MTOK, DM, DFF, 0, 0}; pg8::StaticOrder S2; S2.init(MTOK, DM, G, bx); pg8::EpiNullF EN{0, 0}; pg8::gemm_phase<pg8::EpiNullF, pg8::StaticOrder, true, true>(glds, g2, S2, EN, tid); }
#endif
        } else if (ph == 2 || ph == 7 || ph == 9) {
            LANE_TID
            pg8::Gemm g{ph == 7 ? O : H, (const bf16_t*)(ws + (ph == 2 ? WS_WD1 : ph == 7 ? WS_WOUT : WS_WD2)), MTOK, DM, ph == 7 ? DM : DFF, ph == 7 ? XLD : 0, 0};
            pg8::StaticOrder S; S.init(MTOK, DM, G, bx);
            pg8::EpiResidF E{nullptr, XB, SSP, ph == 7 ? 1.0f : 0.5f, 0};
            pg8::gemm_phase<pg8::EpiResidF, pg8::StaticOrder, true, true>(glds, g, S, E, tid);
        } else if (ph == 3) {
            LANE_TID
            {
                pg8::Gemm g{XB, (const bf16_t*)(ws + WS_WINA), MTOK, 2048, DM, XLD, 0};
                pg8::StaticOrder S; S.init(MTOK, 2048, G, bx);
                pg8::EpiProjAF E{ws, SSP};
                pg8::gemm_phase<pg8::EpiProjAF, pg8::StaticOrder, true, true>(glds, g, S, E, tid);
            }
            {
                pg8::Gemm g{(const bf16_t*)(ws + WS_WINB), XB, 1024, MTOK, DM, 0, XLD};
                pg8::StaticOrder S; S.init(1024, MTOK, G, bx);
                pg8::EpiProjBF E{VT, SSP};
                pg8::gemm_phase<pg8::EpiProjBF, pg8::StaticOrder, true, true>(glds, g, S, E, tid);
            }
        } else if (ph == 4) {
            LANE_TID
            if ((gw & 1) == 0) for (int it = gw >> 1; it < NBATCH * 8 * 16; it += ngw >> 1) kmean_item((const bf16_t*)(ws + WS_KA), (float*)(ws + WS_KMEAN), it, lane);
            {
                const int q = (bx >> 5) & 7, kv = q >> 2, sp = q & 3;
                pg8::Gemm g{(const bf16_t*)(ws + (kv ? WS_VC : WS_KC)) + 256 * sp, (const bf16_t*)(ws + (kv ? WS_W1V : WS_W1K)) + 256 * sp, 4096, 512, 256, 1024, 1024};
                pg8::StaticOrder S; S.init(4096, 512, G, bx & 31);
                pg8::EpiF32F E{(bf16_t*)(ws + WS_P) + (size_t)q * 4096 * 512, 512, 0};
                pg8::gemm_phase<pg8::EpiF32F, pg8::StaticOrder, true, true>(glds, g, S, E, tid);
            }
        } else if (ph == 5) {
            LANE_TID
            for (int grp = bx; grp < 256; grp += G)
                cmp2_group((const float*)(ws + WS_P), (const float*)(ws + WS_BIAS1), a.in[9], a.in[12], (bf16_t*)(ws + WS_KCMP), (bf16_t*)(ws + WS_VCMPT), (LAS3 float*)lds, grp, tid);
        } else if (ph == 6) {
            LANE_TID
            for (int k = 0; k * G < 1024; ++k) {
                int idx = k * G + ((k & 1) ? G - 1 - bx : bx);
                if (G == 256) {
                    const int x = bx & 7, jl = bx >> 3, bhx = 8 * x + 2 * k + (jl >> 4), curx = (k & 1) ? (jl & 15) : 15 - (jl & 15);
                    idx = ((15 - curx) << 6) | bhx;
                }
                if (idx < 1024) fa::moba_unit(lds, (idx & 63) >> 3, idx & 7, 15 - (idx >> 6), (const bf16_t*)(ws + WS_QA), (const bf16_t*)(ws + WS_KA), VT, (const float*)(ws + WS_KMEAN), (const float*)(ws + WS_BLUT), O, wave);
            }
#ifndef PROBE_NSA
#define PROBE_NSA 0
#endif
            for (int rep_ = 0; rep_ <= PROBE_NSA; ++rep_)
            for (int k = 0; k * G < 1024; ++k) {
                int idx = k * G + ((k & 1) ? G - 1 - bx : bx);
                if (G == 256) {
                    const int x = bx & 7, jl = bx >> 3, bgx = 2 * x + (k >> 1), cx = (k & 1) ? jl : 63 - jl;
                    idx = ((63 - cx) << 4) | bgx;
                }
                if (idx < 1024) fa::nsa_unit(lds, (idx & 15) >> 1, idx & 1, 63 - (idx >> 4), (const bf16_t*)(ws + WS_QB), (const bf16_t*)(ws + WS_KCMP), (const bf16_t*)(ws + WS_VCMPT), (const bf16_t*)(ws + WS_KS), (const bf16_t*)(ws + WS_KW), VT, (const float*)(ws + WS_BLUT), O, wave);
            }
        } else if (ph == 10) {
            LANE_TID
            for (int row = gw; row < MTOK; row += 4 * ngw) { const int rows[4] = {row, row + ngw, row + 2 * ngw, row + 3 * ngw}; final_rows<4>(XB, SSP, out, a.in[19], rows, lane); }
        }
        if (ph0 + 1 < a.ph_hi) {
            XcdBarrier xbar; xbar.bar = (unsigned*)(ws + WS_BAR); xbar.x = xb_xcc_id(); xbar.st = bar_st;
            xcd_barrier(xbar);
        }
    }
}

extern "C" void kernel_launch(void* const* d_in, const int* in_sizes, int n_in, void* d_out, int out_size, void* d_ws, size_t ws_size, hipStream_t stream) {
    static int grid_blocks = 0;
    if (grid_blocks == 0) {
        if (n_in != 20 || ws_size < WS_END) { fprintf(stderr, "kernel_launch: unexpected n_in %d / ws_size %zu\n", n_in, ws_size); grid_blocks = -1; return; }
        int dev = 0, cus = 0, per_cu = 0;
        hipGetDevice(&dev);
        hipDeviceGetAttribute(&cus, hipDeviceAttributeMultiprocessorCount, dev);
        hipFuncSetAttribute((const void*)mega, hipFuncAttributeMaxDynamicSharedMemorySize, LDS_BYTES);
        hipOccupancyMaxActiveBlocksPerMultiprocessor(&per_cu, (const void*)mega, 512, LDS_BYTES);
        if (per_cu < 1) { fprintf(stderr, "kernel_launch: occupancy query says %d blocks/CU\n", per_cu); per_cu = 1; }
        if (per_cu > 1) per_cu = 1;
        grid_blocks = cus * per_cu;
        if (grid_blocks != 256) { fprintf(stderr, "kernel_launch: this build expects 256 workgroups (256 CUs x 1), got %d\n", grid_blocks); grid_blocks = -1; return; }
        fprintf(stderr, "kernel_launch: grid %d blocks (%d CUs)\n", grid_blocks, cus);
    }
    if (grid_blocks < 0) return;
    MegaArgs a{};
    for (int i = 0; i < 20; ++i) a.in[i] = (const float*)d_in[i];
    a.out = (float*)d_out; a.ws = (unsigned char*)d_ws; a.ph_lo = 0; a.ph_hi = NPHASE;
    void* args[] = {&a};
    hipMemsetAsync(d_ws, 0, XCD_BAR_WORDS * sizeof(unsigned), stream);
    hipError_t e = hipLaunchCooperativeKernel((const void*)mega, dim3(grid_blocks), dim3(512), args, LDS_BYTES, stream);
    if (e != hipSuccess) fprintf(stderr, "cooperative launch failed: %s (grid %d)\n", hipGetErrorString(e), grid_blocks);
}
```
